# Optimizing an MI355X kernel written in HIP

```python
import math
import jax
import jax.numpy as jnp
from jax import lax
import numpy as np

D_MODEL = 1024
BATCH = 4
SEQ = 4096
DEPTH = 2

GRID_W = 64
CTX_LEN = 256
RMS_EPS = 1e-6
GN_EPS = 1e-5
N_BRANCH = 3
MIX_W = 512

RET_HEADS = 4
RET_DK = 128
RET_DV = MIX_W // RET_HEADS
RET_QK_W = RET_HEADS * RET_DK
RET_CHUNK = 128

S5_GROUP = 16
S5_GROUPS = MIX_W // S5_GROUP
S5_STATE = 64
S5_DT_MIN = 1e-3
S5_DT_MAX = 1e-1

HY_SHORT = 3
HY_EMB = 33
HY_BANDS = (HY_EMB - 1) // 2
HY_FHID = 64
HY_DECAY_TARGET = 1e-2
HY_FAST_PCT = 0.3
HY_SLOW_PCT = 1.5

MOE_GROUPS = 4
MOE_PER_GROUP = 8
MOE_EXPERTS = MOE_GROUPS * MOE_PER_GROUP
MOE_HIDDEN = 512
MOE_TOPK = 2
MOE_BLOCK = 128

COL_Q = 0
COL_K = COL_Q + RET_QK_W
COL_V = COL_K + RET_QK_W
COL_G = COL_V + MIX_W
COL_S5 = COL_G + MIX_W
COL_HY = COL_S5 + MIX_W
COL_GATE = COL_HY + 3 * MIX_W
IN_COLS = COL_GATE + N_BRANCH * D_MODEL

kernel_name = 'hybrid_retention_s5_hyena_hmoe_flow_block'


def rms_norm(x, g):
    xf = x.astype(jnp.float32)
    y = xf * lax.rsqrt(jnp.mean(xf * xf, axis=-1, keepdims=True) + RMS_EPS)
    return (y * g.astype(jnp.float32)).astype(x.dtype)


def grid_pos_embed(n_tokens, dtype):
    rows = n_tokens // GRID_W
    quarter = D_MODEL // 4
    omega = 1.0 / (10000.0 ** (jnp.arange(quarter, dtype=jnp.float32) / quarter))
    ang_r = jnp.arange(rows, dtype=jnp.float32)[:, None] * omega
    ang_c = jnp.arange(GRID_W, dtype=jnp.float32)[:, None] * omega
    emb_r = jnp.concatenate([jnp.sin(ang_r), jnp.cos(ang_r)], axis=-1)
    emb_c = jnp.concatenate([jnp.sin(ang_c), jnp.cos(ang_c)], axis=-1)
    half = D_MODEL // 2
    pe = jnp.concatenate([jnp.broadcast_to(emb_r[:, None, :], (rows, GRID_W, half)),
                          jnp.broadcast_to(emb_c[None, :, :], (rows, GRID_W, half))], axis=-1)
    return pe.reshape(rows * GRID_W, D_MODEL).astype(dtype)


def _heads(t):
    return t.astype(jnp.float32).reshape(t.shape[0], t.shape[1], RET_HEADS, -1)


def _ret_masks(log_gamma, include_diag):
    lg = log_gamma.astype(jnp.float32)
    idx = jnp.arange(RET_CHUNK, dtype=jnp.float32)
    diff = idx[:, None] - idx[None, :]
    keep = (diff >= 0) if include_diag else (diff > 0)
    inner = jnp.where(keep[None], jnp.exp(lg[:, None, None] * jnp.maximum(diff, 0.0)[None]), 0.0)
    q_dec = jnp.exp(lg[:, None] * (idx + 1.0)[None])
    k_dec = jnp.exp(lg[:, None] * (RET_CHUNK - 1.0 - idx)[None])
    c_dec = jnp.exp(lg * RET_CHUNK)
    return inner, q_dec, k_dec, c_dec


def retention_scan(q, k, v, log_gamma, s0, include_diag):
    bsz, n_tok = q.shape[0], q.shape[1]
    n_chunks = n_tok // RET_CHUNK

    def chunks(t):
        return t.reshape(bsz, n_chunks, RET_CHUNK, RET_HEADS, t.shape[-1]).transpose(1, 0, 3, 2, 4)

    inner, q_dec, k_dec, c_dec = _ret_masks(log_gamma, include_diag)

    def step(s, qkv):
        qi, ki, vi = qkv
        att = jnp.einsum('bhid,bhjd->bhij', qi, ki) * inner
        o = jnp.einsum('bhij,bhje->bhie', att, vi) + jnp.einsum('bhid,bhde->bhie', qi * q_dec[..., None], s)
        s = s * c_dec[:, None, None] + jnp.einsum('bhjd,bhje->bhde', ki * k_dec[..., None], vi)
        return s, o

    _, o = lax.scan(step, s0, (chunks(q), chunks(k), chunks(v)))
    return o.transpose(1, 0, 3, 2, 4).reshape(bsz, n_tok, RET_HEADS, RET_DV)


def retention_state(k, v, log_gamma):
    n_tok = k.shape[1]
    dist = (n_tok - 1 - jnp.arange(n_tok)).astype(jnp.float32)
    w = jnp.exp(dist[:, None] * log_gamma.astype(jnp.float32)[None])
    return jnp.einsum('blhd,lh,blhe->bhde', k, w, v)


def bi_retention(q, k, v, log_decay, s0_f, s0_b):
    flip = lambda t: jnp.flip(t, axis=1)
    o_f = retention_scan(q, k, v, log_decay[0], s0_f, True)
    o_b = retention_scan(flip(q), flip(k), flip(v), log_decay[1], s0_b, False)
    return o_f + flip(o_b)


def retention_readout(o, g, gn_g):
    mu = jnp.mean(o, axis=-1, keepdims=True)
    var = jnp.mean(jnp.square(o - mu), axis=-1, keepdims=True)
    on = ((o - mu) * lax.rsqrt(var + GN_EPS)).reshape(g.shape) * gn_g.astype(jnp.float32)
    return (on * jax.nn.silu(g.astype(jnp.float32))).astype(g.dtype)


def _s5_groups(t):
    return t.astype(jnp.float32).reshape(t.shape[0], t.shape[1], S5_GROUPS, S5_GROUP).astype(jnp.complex64)


def s5_discretize(lam_re, lam_im, log_dt, b_re, b_im):
    lam = lax.complex(lam_re.astype(jnp.float32), lam_im.astype(jnp.float32))
    lam_dt = lam * jnp.exp(log_dt.astype(jnp.float32))[:, None]
    a_bar = jnp.exp(lam_dt)
    bmat = lax.complex(b_re.astype(jnp.float32), b_im.astype(jnp.float32))
    b_bar = ((a_bar - 1.0) / lam)[..., None] * bmat
    return lam_dt, a_bar, b_bar


def s5_state(u, lam_dt, b_bar):
    n_tok = u.shape[1]
    dist = (n_tok - 1 - jnp.arange(n_tok)).astype(jnp.float32)
    pw = jnp.exp(dist[:, None, None] * lam_dt[None])
    return jnp.einsum('lgn,gnp,blgp->bgn', pw, b_bar, u)


def s5_scan(u, a_bar, b_bar, c, h0, reverse):
    bu = jnp.einsum('gnp,blgp->blgn', b_bar, u)
    if reverse:
        bu = jnp.flip(bu, axis=1)
    bu = bu.at[:, 0].add(a_bar[None] * h0)
    a = jnp.broadcast_to(a_bar, bu.shape)

    def combine(e1, e2):
        return e1[0] * e2[0], e2[0] * e1[1] + e2[1]

    _, h = lax.associative_scan(combine, (a, bu), axis=1)
    if reverse:
        h = jnp.flip(h, axis=1)
    return jnp.einsum('gpn,blgn->blgp', c, h).real


def s5_readout(y, u, d, glu_w1, glu_w2):
    yy = y.reshape(u.shape) + d.astype(jnp.float32) * u.astype(jnp.float32)
    g = jax.nn.gelu(yy)
    return ((g @ glu_w1.astype(jnp.float32)) * jax.nn.sigmoid(g @ glu_w2.astype(jnp.float32))).astype(u.dtype)


def s5_mixer(u, uc, lam_re, lam_im, log_dt, b_re, b_im, c_re, c_im, d, glu_w1, glu_w2, need_ctx):
    ul, ucl = _s5_groups(u), _s5_groups(uc)
    y = 0.0
    yc = 0.0
    for direction in range(2):
        rev = direction == 1
        lam_dt, a_bar, b_bar = s5_discretize(lam_re[direction], lam_im[direction], log_dt[direction],
                                             b_re[direction], b_im[direction])
        cmat = lax.complex(c_re[direction].astype(jnp.float32), c_im[direction].astype(jnp.float32))
        h0 = s5_state(jnp.flip(ucl, axis=1) if rev else ucl, lam_dt, b_bar)
        y = y + s5_scan(ul, a_bar, b_bar, cmat, h0, rev)
        if need_ctx:
            yc = yc + s5_scan(ucl, a_bar, b_bar, cmat, jnp.zeros_like(h0), rev)
    out = s5_readout(y, u, d, glu_w1, glu_w2)
    out_c = s5_readout(yc, uc, d, glu_w1, glu_w2) if need_ctx else None
    return out, out_c


def short_conv(z, w, b):
    zp = jnp.pad(z, ((0, 0), (1, 1), (0, 0)))
    return zp[:, :-2] * w[0] + zp[:, 1:-1] * w[1] + zp[:, 2:] * w[2] + b


def hyena_filter(n_tok, w1, b1, w2, b2, w3, freq):
    f32 = jnp.float32
    t = jnp.linspace(0.0, 1.0, n_tok, dtype=f32)[:, None]
    w = 2.0 * math.pi * jnp.arange(n_tok, dtype=f32)[:, None] / n_tok
    f = jnp.linspace(1e-4, HY_BANDS - 1, HY_BANDS, dtype=f32)[None]
    z = jnp.concatenate([t, jnp.cos(f * w), -jnp.sin(f * w)], axis=-1)
    freq = freq.astype(f32)
    h = jnp.sin(freq[0] * (z @ w1.astype(f32) + b1.astype(f32)))
    h = jnp.sin(freq[1] * (h @ w2.astype(f32) + b2.astype(f32)))
    h = h @ w3.astype(f32)
    offset = jnp.abs(jnp.arange(n_tok) - n_tok // 2).astype(f32) / n_tok
    deltas = jnp.abs(jnp.linspace(math.log(HY_DECAY_TARGET) / HY_SLOW_PCT,
                                  math.log(HY_DECAY_TARGET) / HY_FAST_PCT, MIX_W, dtype=f32))
    return h * jnp.exp(-offset[:, None] * deltas[None])


def long_conv_centred(u, h):
    n_tok = u.shape[1]
    n_fft = 2 * n_tok
    y = jnp.fft.irfft(jnp.fft.rfft(u, n=n_fft, axis=1) * jnp.fft.rfft(h, n=n_fft, axis=0)[None], n=n_fft, axis=1)
    return y[:, n_tok // 2: n_tok // 2 + n_tok]


def hyena_seq(z, short_w, short_b, filt, bias):
    zs = short_conv(z, short_w, short_b).astype(jnp.float32)
    x0, x1, v = jnp.split(zs, 3, axis=-1)
    y = x1 * v
    y = long_conv_centred(y, filt) + y * bias.astype(jnp.float32)
    return (x0 * y).astype(z.dtype)


def merge_branches(ys, gate_logits, w_branch, w_out):
    y = jnp.stack(ys, axis=2)
    branch = jnp.einsum('blnc,ncd->blnd', y, w_branch)
    gates = jax.nn.sigmoid(gate_logits.astype(jnp.float32)).astype(branch.dtype).reshape(branch.shape)
    return jnp.sum(gates * branch, axis=2) @ w_out


def token_mixer(h, hc, w_in, ret_log_decay, ret_gn_g,
                s5_lambda_re, s5_lambda_im, s5_log_dt, s5_b_re, s5_b_im, s5_c_re, s5_c_im, s5_d,
                s5_glu_w1, s5_glu_w2, hy_short_w, hy_short_b, hy_f_w1, hy_f_b1, hy_f_w2, hy_f_b2,
                hy_f_w3, hy_f_freq, hy_bias, w_branch, w_out, need_ctx):
    z = h @ w_in
    if need_ctx:
        zc = hc @ w_in
        kvc, uc = zc[..., COL_K:COL_G], zc[..., COL_S5:COL_HY]
    else:
        kvc = hc @ w_in[:, COL_K:COL_G]
        uc = hc @ w_in[:, COL_S5:COL_HY]
    kc, vc = _heads(kvc[..., :RET_QK_W]), _heads(kvc[..., RET_QK_W:])
    q_scale = RET_DK ** -0.5

    s_f = retention_state(kc, vc, ret_log_decay[0])
    s_b = retention_state(jnp.flip(kc, axis=1), jnp.flip(vc, axis=1), ret_log_decay[1])
    q = _heads(z[..., COL_Q:COL_K]) * q_scale
    o = bi_retention(q, _heads(z[..., COL_K:COL_V]), _heads(z[..., COL_V:COL_G]), ret_log_decay, s_f, s_b)
    y_ret = retention_readout(o, z[..., COL_G:COL_S5], ret_gn_g)

    y_s5, y_s5c = s5_mixer(z[..., COL_S5:COL_HY], uc, s5_lambda_re, s5_lambda_im, s5_log_dt,
                           s5_b_re, s5_b_im, s5_c_re, s5_c_im, s5_d, s5_glu_w1, s5_glu_w2, need_ctx)

    filt_p = (hy_f_w1, hy_f_b1, hy_f_w2, hy_f_b2, hy_f_w3, hy_f_freq)
    y_hy = hyena_seq(z[..., COL_HY:COL_GATE], hy_short_w, hy_short_b, hyena_filter(z.shape[1], *filt_p), hy_bias)

    out = merge_branches((y_ret, y_s5, y_hy), z[..., COL_GATE:], w_branch, w_out)
    if not need_ctx:
        return out, None

    zero_s = jnp.zeros_like(s_f)
    qc = _heads(zc[..., COL_Q:COL_K]) * q_scale
    y_retc = retention_readout(bi_retention(qc, kc, vc, ret_log_decay, zero_s, zero_s), zc[..., COL_G:COL_S5], ret_gn_g)
    y_hyc = hyena_seq(zc[..., COL_HY:COL_GATE], hy_short_w, hy_short_b, hyena_filter(zc.shape[1], *filt_p), hy_bias)
    out_c = merge_branches((y_retc, y_s5c, y_hyc), zc[..., COL_GATE:], w_branch, w_out)
    return out, out_c


def grouped_expert_ffn(t, expert_ids, weights, w1, w3, w2):
    n_tok, d = t.shape
    n_slots = expert_ids.shape[0]
    k = n_slots // n_tok
    token = jnp.arange(n_slots) // k
    order = jnp.argsort(expert_ids)
    e_sorted, tok_sorted, w_sorted = expert_ids[order], token[order], weights[order]
    counts = jnp.bincount(expert_ids, length=MOE_EXPERTS)
    padded = (counts + MOE_BLOCK - 1) // MOE_BLOCK * MOE_BLOCK
    starts = jnp.cumsum(counts) - counts
    pends = jnp.cumsum(padded)
    pstarts = pends - padded
    dest = pstarts[e_sorted] + jnp.arange(n_slots) - starts[e_sorted]
    n_blocks = -(-n_slots // MOE_BLOCK) + MOE_EXPERTS
    buf = jnp.zeros((n_blocks * MOE_BLOCK, d), t.dtype).at[dest].set(t[tok_sorted])
    block_expert = jnp.minimum(jnp.searchsorted(pends, jnp.arange(n_blocks) * MOE_BLOCK, side='right'),
                               MOE_EXPERTS - 1)

    def expert_block(args):
        xb, e = args
        return (jax.nn.silu(xb @ w1[e]) * (xb @ w3[e])) @ w2[e]

    ybuf = lax.map(expert_block, (buf.reshape(n_blocks, MOE_BLOCK, d), block_expert)).reshape(-1, d)
    out = jnp.zeros((n_tok, d), jnp.float32).at[tok_sorted].add(ybuf[dest].astype(jnp.float32) * w_sorted[:, None])
    return out.astype(t.dtype)


def hier_moe(t, w_group, b_group, w_expert, b_expert, w1, w3, w2):
    n_tok = t.shape[0]
    tf = t.astype(jnp.float32)
    p_group = jax.nn.softmax(tf @ w_group.astype(jnp.float32) + b_group.astype(jnp.float32), axis=-1)
    p_top, g_idx = lax.top_k(p_group, 1)
    logits = (tf @ w_expert.astype(jnp.float32) + b_expert.astype(jnp.float32)).reshape(n_tok, MOE_GROUPS, MOE_PER_GROUP)
    in_group = jnp.take_along_axis(logits, g_idx[:, :, None], axis=1)[:, 0]
    l_top, e_idx = lax.top_k(in_group, MOE_TOPK)
    weights = jax.nn.softmax(l_top, axis=-1) * p_top
    experts = g_idx * MOE_PER_GROUP + e_idx
    return grouped_expert_ffn(t, experts.reshape(-1), weights.reshape(-1), w1, w3, w2)


def setup_inputs(seed: int = 0) -> dict:
    key = jax.random.key(seed)
    keys = iter(jax.random.split(key, 64))
    f32 = jnp.float32

    def normal(shape, scale):
        return jax.random.normal(next(keys), shape, f32) * scale

    d = D_MODEL
    g, n, p = S5_GROUPS, S5_STATE, S5_GROUP
    ret_base = jnp.log1p(-(2.0 ** (-5.0 - jnp.arange(RET_HEADS, dtype=f32))))
    return {
        'x': normal((BATCH, SEQ, d), 1.0),
        'c': normal((BATCH, d), 1.0),
        'ctx': normal((BATCH, CTX_LEN, d), 1.0),
        'c_ctx': normal((d,), 1.0),
        'w_mod': normal((DEPTH, d, 6 * d), 0.5 * d ** -0.5),
        'b_mod': normal((DEPTH, 6 * d), 0.01),
        'norm1_g': 1.0 + normal((DEPTH, d), 0.01),
        'norm2_g': 1.0 + normal((DEPTH, d), 0.01),
        'w_in': normal((DEPTH, d, IN_COLS), d ** -0.5),
        'ret_log_decay': ret_base * (1.0 + normal((DEPTH, 2, RET_HEADS), 0.05)),
        'ret_gn_g': 1.0 + normal((DEPTH, MIX_W), 0.01),
        's5_lambda_re': -0.5 + normal((DEPTH, 2, g, n), 0.01),
        's5_lambda_im': math.pi * jnp.arange(n, dtype=f32) + normal((DEPTH, 2, g, n), 0.01),
        's5_log_dt': jax.random.uniform(next(keys), (DEPTH, 2, g), f32, math.log(S5_DT_MIN), math.log(S5_DT_MAX)),
        's5_b_re': normal((DEPTH, 2, g, n, p), (2 * p) ** -0.5),
        's5_b_im': normal((DEPTH, 2, g, n, p), (2 * p) ** -0.5),
        's5_c_re': normal((DEPTH, 2, g, p, n), n ** -0.5),
        's5_c_im': normal((DEPTH, 2, g, p, n), n ** -0.5),
        's5_d': normal((DEPTH, MIX_W), 1.0),
        's5_glu_w1': normal((DEPTH, MIX_W, MIX_W), MIX_W ** -0.5),
        's5_glu_w2': normal((DEPTH, MIX_W, MIX_W), MIX_W ** -0.5),
        'hy_short_w': normal((DEPTH, HY_SHORT, 3 * MIX_W), 0.5),
        'hy_short_b': normal((DEPTH, 3 * MIX_W), 0.01),
        'hy_f_w1': normal((DEPTH, HY_EMB, HY_FHID), HY_EMB ** -0.5),
        'hy_f_b1': normal((DEPTH, HY_FHID), 0.1),
        'hy_f_w2': normal((DEPTH, HY_FHID, HY_FHID), HY_FHID ** -0.5),
        'hy_f_b2': normal((DEPTH, HY_FHID), 0.1),
        'hy_f_w3': normal((DEPTH, HY_FHID, MIX_W), 0.05 * HY_FHID ** -0.5),
        'hy_f_freq': 1.0 + normal((DEPTH, 2, HY_FHID), 0.01),
        'hy_bias': normal((DEPTH, MIX_W), 0.5),
        'w_branch': normal((DEPTH, N_BRANCH, MIX_W, d), MIX_W ** -0.5),
        'w_out': normal((DEPTH, d, d), d ** -0.5),
        'moe_w_group': normal((DEPTH, d, MOE_GROUPS), d ** -0.5),
        'moe_b_group': normal((DEPTH, MOE_GROUPS), 0.01),
        'moe_w_expert': normal((DEPTH, d, MOE_EXPERTS), d ** -0.5),
        'moe_b_expert': normal((DEPTH, MOE_EXPERTS), 0.01),
        'moe_w1': normal((DEPTH, MOE_EXPERTS, d, MOE_HIDDEN), d ** -0.5),
        'moe_w3': normal((DEPTH, MOE_EXPERTS, d, MOE_HIDDEN), d ** -0.5),
        'moe_w2': normal((DEPTH, MOE_EXPERTS, MOE_HIDDEN, d), MOE_HIDDEN ** -0.5),
        'final_norm_g': 1.0 + normal((d,), 0.01),
    }


def reference(x, c, ctx, c_ctx, w_mod, b_mod, norm1_g, norm2_g, w_in, ret_log_decay, ret_gn_g,
              s5_lambda_re, s5_lambda_im, s5_log_dt, s5_b_re, s5_b_im, s5_c_re, s5_c_im, s5_d,
              s5_glu_w1, s5_glu_w2, hy_short_w, hy_short_b, hy_f_w1, hy_f_b1, hy_f_w2, hy_f_b2,
              hy_f_w3, hy_f_freq, hy_bias, w_branch, w_out, moe_w_group, moe_b_group,
              moe_w_expert, moe_b_expert, moe_w1, moe_w3, moe_w2, final_norm_g):
    bsz, n_lat, d = x.shape
    x = x + grid_pos_embed(n_lat, x.dtype)[None]
    xc = ctx
    silu_c = jax.nn.silu(c)
    silu_cc = jax.nn.silu(c_ctx)
    for l in range(DEPTH):
        last = l == DEPTH - 1
        mod = (silu_c @ w_mod[l] + b_mod[l])[:, None, :]
        sh1, sc1, g1, sh2, sc2, g2 = jnp.split(mod, 6, axis=-1)
        n_ctx_mod = 2 if last else 6
        modc = (silu_cc @ w_mod[l][:, :n_ctx_mod * d] + b_mod[l][:n_ctx_mod * d])[None, None, :]
        cm = jnp.split(modc, n_ctx_mod, axis=-1)
        h = rms_norm(x, norm1_g[l]) * (1 + sc1) + sh1
        hc = rms_norm(xc, norm1_g[l]) * (1 + cm[1]) + cm[0]
        mix, mix_c = token_mixer(h, hc, w_in[l], ret_log_decay[l], ret_gn_g[l],
                                 s5_lambda_re[l], s5_lambda_im[l], s5_log_dt[l], s5_b_re[l], s5_b_im[l],
                                 s5_c_re[l], s5_c_im[l], s5_d[l], s5_glu_w1[l], s5_glu_w2[l],
                                 hy_short_w[l], hy_short_b[l], hy_f_w1[l], hy_f_b1[l], hy_f_w2[l], hy_f_b2[l],
                                 hy_f_w3[l], hy_f_freq[l], hy_bias[l], w_branch[l], w_out[l],
                                 need_ctx=not last)
        x = x + g1 * mix
        h2 = rms_norm(x, norm2_g[l]) * (1 + sc2) + sh2
        moe_p = (moe_w_group[l], moe_b_group[l], moe_w_expert[l], moe_b_expert[l], moe_w1[l], moe_w3[l], moe_w2[l])
        if last:
            x = x + g2 * hier_moe(h2.reshape(-1, d), *moe_p).reshape(x.shape)
        else:
            xc = xc + cm[2] * mix_c
            h2c = rms_norm(xc, norm2_g[l]) * (1 + cm[4]) + cm[3]
            y = hier_moe(jnp.concatenate([h2.reshape(-1, d), h2c.reshape(-1, d)], axis=0), *moe_p)
            x = x + g2 * y[: bsz * n_lat].reshape(x.shape)
            xc = xc + cm[5] * y[bsz * n_lat:].reshape(xc.shape)
    return rms_norm(x, final_norm_g)
```

```cpp
#include <hip/hip_runtime.h>
#include <hip/hip_cooperative_groups.h>
#include <cstdio>
#include <cstdint>
namespace cg = cooperative_groups;


typedef unsigned short bf16_t;
constexpr int NB = 4, L = 4096, LC = 256, D = 1024;
constexpr int RL = NB * L, RC = NB * LC, R = RL + RC;
constexpr int INC = 7168;
constexpr int COL_K = 512, COL_V = 1024, COL_G = 1536, COL_S5 = 2048, COL_HY = 2560, COL_GATE = 4096;
constexpr int NEXP = 32, MOEH = 512, SLOTCAP = R;
constexpr int NT = 512;
constexpr int NPHASE = 18;
constexpr int LDS_BYTES = 147456;

constexpr size_t MiB = 1u << 20;
constexpr size_t OFF_CTL = 0;
constexpr size_t OFF_XC = 1 * MiB;
constexpr size_t OFF_MOD = 5 * MiB;
constexpr size_t OFF_FILT = 6 * MiB;
constexpr size_t OFF_FILTC = 22 * MiB;
constexpr size_t OFF_ROUTE_E = 23 * MiB;
constexpr size_t OFF_ROUTE_W = 23 * MiB + 256 * 1024;
constexpr size_t OFF_SLOTPOS = 23 * MiB + 512 * 1024;
constexpr size_t OFF_SLOTTOK = 24 * MiB;
constexpr size_t OFF_H = 27 * MiB;
constexpr size_t OFF_MERGED = OFF_H;
constexpr size_t OFF_EOUT = OFF_H;
constexpr size_t OFF_YCAT = 61 * MiB;
constexpr size_t OFF_DST = OFF_YCAT;
constexpr size_t OFF_QP = 112 * MiB;
constexpr size_t OFF_KR = 129 * MiB;
constexpr size_t OFF_YHYT = OFF_KR;
constexpr size_t OFF_YHYTC = OFF_KR + 16 * MiB;
constexpr size_t OFF_AO = 146 * MiB;
constexpr size_t OFF_KT2 = 214 * MiB;
constexpr size_t OFF_BO = 248 * MiB;
constexpr size_t OFF_HID = OFF_AO;
constexpr size_t OFF_YBUF = OFF_AO + 42 * MiB;
constexpr size_t OFF_ZG = 283 * MiB;
constexpr size_t OFF_AY = 300 * MiB;
constexpr size_t OFF_ZHYT = 340 * MiB;
constexpr size_t OFF_ZHYTC = OFF_ZHYT + 48 * MiB;
constexpr size_t OFF_G = OFF_ZHYT;
constexpr size_t OFF_OR = OFF_ZHYT + 17 * MiB;
constexpr size_t OFF_ZGATE = 391 * MiB;
constexpr size_t OFF_UP_T = 276 * MiB;
constexpr size_t OFF_DN_T = OFF_QP;
constexpr size_t OFF_W = 493 * MiB;
constexpr size_t OFF_WIN_T = OFF_W;
constexpr size_t OFF_GLU_T = OFF_W + 14 * MiB;
constexpr size_t OFF_BR_T = OFF_W + 15 * MiB;
constexpr size_t OFF_OUT_T = OFF_W + 18 * MiB;
constexpr size_t OFF_PE = 513 * MiB;
constexpr size_t OFF_PY = 521 * MiB;
constexpr size_t WS_NEED = 537 * MiB;
constexpr int LDS_SH = 131072;

enum { I_X = 0, I_C, I_CTX, I_CCTX, I_WMOD, I_BMOD, I_N1G, I_N2G, I_WIN, I_RETDEC, I_RETGN, I_LRE, I_LIM, I_LOGDT, I_BRE, I_BIM, I_CRE, I_CIM,
       I_S5D, I_GLU1, I_GLU2, I_HYSW, I_HYSB, I_HYW1, I_HYB1, I_HYW2, I_HYB2, I_HYW3, I_HYFREQ, I_HYBIAS, I_WBR, I_WOUT, I_MWG, I_MBG, I_MWE, I_MBE,
       I_MW1, I_MW3, I_MW2, I_FNG, N_IN };

struct Params { const float* in[N_IN]; float* out; unsigned char* ws; };

__device__ __forceinline__ float bf2f(bf16_t v) { return __uint_as_float(((unsigned)v) << 16); }
__device__ __forceinline__ bf16_t f2bf(float f) { unsigned u = __float_as_uint(f); return (bf16_t)((u + 0x7fffu + ((u >> 16) & 1u)) >> 16); }
__device__ __forceinline__ float sigmoidf_(float x) { return __builtin_amdgcn_rcpf(1.f + __expf(-x)); }
__device__ __forceinline__ float siluf_(float x) { return x * __builtin_amdgcn_rcpf(1.f + __expf(-x)); }
__device__ __forceinline__ float gelu_tanh_(float x) {
    const float z = 0.7978845608028654f * (x + 0.044715f * x * x * x);
    return x * (1.f - __builtin_amdgcn_rcpf(1.f + __expf(2.f * z)));
}
__device__ __forceinline__ float shx(float v, int mask, int lane) { return __int_as_float(__builtin_amdgcn_ds_bpermute((lane ^ mask) << 2, __float_as_int(v))); }
__device__ __forceinline__ float shl_(float v, int src) { return __int_as_float(__builtin_amdgcn_ds_bpermute(src << 2, __float_as_int(v))); }
__device__ __forceinline__ float wave_sum_dpp(float v) {
    int x = __float_as_int(v);
    x = __float_as_int(__int_as_float(x) + __int_as_float(__builtin_amdgcn_update_dpp(0, x, 0xB1, 0xF, 0xF, true)));
    x = __float_as_int(__int_as_float(x) + __int_as_float(__builtin_amdgcn_update_dpp(0, x, 0x4E, 0xF, 0xF, true)));
    x = __float_as_int(__int_as_float(x) + __int_as_float(__builtin_amdgcn_update_dpp(0, x, 0x141, 0xF, 0xF, true)));
    x = __float_as_int(__int_as_float(x) + __int_as_float(__builtin_amdgcn_update_dpp(0, x, 0x140, 0xF, 0xF, true)));
    x = __float_as_int(__int_as_float(x) + __int_as_float(__builtin_amdgcn_update_dpp(0, x, 0x142, 0xA, 0xF, true)));
    x = __float_as_int(__int_as_float(x) + __int_as_float(__builtin_amdgcn_update_dpp(0, x, 0x143, 0xC, 0xF, true)));
    return __int_as_float(__builtin_amdgcn_readlane(x, 63));
}
__device__ __forceinline__ float wave_sum(float v, int lane) {
#pragma unroll
    for (int o = 32; o >= 1; o >>= 1) v += shx(v, o, lane);
    return v;
}

typedef const __attribute__((address_space(4))) Params* KParams;
struct Ctx {
    KParams p; unsigned char* ws; float* X; float* smem; int tid, lane, wave, bid, nblk;
};
__device__ __forceinline__ int opq(int v) { int z = 0; asm volatile("" : "+v"(z)); return v + z; }
#define WSF(name, type, off) __device__ __forceinline__ type* name(const Ctx& c) { return (type*)(c.ws + (off)); }
WSF(cPET, float, OFF_MOD + 512 * 1024) WSF(cXC, float, OFF_XC) WSF(cMOD, float, OFF_MOD) WSF(cFILT, bf16_t, OFF_FILT) WSF(cFILTC, bf16_t, OFF_FILTC) WSF(cYHYT, bf16_t, OFF_YHYT) WSF(cYHYTC, bf16_t, OFF_YHYTC) WSF(cROUTE_E, int, OFF_ROUTE_E) WSF(cROUTE_W, float, OFF_ROUTE_W)
WSF(cSLOTPOS, int, OFF_SLOTPOS) WSF(cSLOTTOK, int, OFF_SLOTTOK) WSF(cH, bf16_t, OFF_H) WSF(cG, bf16_t, OFF_G) WSF(cMERGED, bf16_t, OFF_MERGED) WSF(cYCAT, bf16_t, OFF_YCAT)
WSF(cWINT, bf16_t, OFF_WIN_T) WSF(cGLUT, bf16_t, OFF_GLU_T) WSF(cBRT, bf16_t, OFF_BR_T) WSF(cOUTT, bf16_t, OFF_OUT_T) WSF(cUPT, bf16_t, OFF_UP_T) WSF(cDNT, bf16_t, OFF_DN_T)
WSF(cAY, bf16_t, OFF_AY) WSF(cEOUT, float, OFF_EOUT) WSF(cPE, bf16_t, OFF_PE) WSF(cPY, bf16_t, OFF_PY) WSF(cDST, float, OFF_DST) WSF(cQP, bf16_t, OFF_QP) WSF(cKR, bf16_t, OFF_KR)
WSF(cAO, bf16_t, OFF_AO) WSF(cKT2, bf16_t, OFF_KT2) WSF(cBO, bf16_t, OFF_BO) WSF(cZG, bf16_t, OFF_ZG) WSF(cZHYT, bf16_t, OFF_ZHYT) WSF(cZHYTC, bf16_t, OFF_ZHYTC) WSF(cOR, bf16_t, OFF_OR) WSF(cZGATE, bf16_t, OFF_ZGATE) WSF(cHID, bf16_t, OFF_HID) WSF(cYBUF, bf16_t, OFF_YBUF) WSF(cCNT, int, OFF_CTL)

template <int NBM, class ARow>
__device__ __forceinline__ void gemm_acc(float (&acc)[NBM][4][4], const ARow& arow, const float* B0, const float* B1, int ldb, int K, float* smem, int tid) {
    const int ty = tid >> 4, tx = tid & 15;
    float* As = smem;
    float* Bs0 = smem + 16 * 132;
    float* Bs1 = Bs0 + 16 * 64;
    const int arow_i = tid >> 2, akq = (tid & 3) * 4;
    const bf16_t* ap = arow(arow_i);
    const int bk = tid >> 5, bn = (tid & 31) * 2;
#pragma unroll 1
    for (int k0 = 0; k0 < K; k0 += 16) {
        ushort4 av = make_ushort4(0, 0, 0, 0);
        if (ap) av = *(const ushort4*)(ap + k0 + akq);
        const float2 bv0 = *(const float2*)(B0 + (size_t)(k0 + bk) * ldb + bn);
        float2 bv1 = make_float2(0.f, 0.f);
        if (NBM == 2) bv1 = *(const float2*)(B1 + (size_t)(k0 + bk) * ldb + bn);
        __syncthreads();
        As[(akq + 0) * 132 + arow_i] = bf2f(av.x); As[(akq + 1) * 132 + arow_i] = bf2f(av.y);
        As[(akq + 2) * 132 + arow_i] = bf2f(av.z); As[(akq + 3) * 132 + arow_i] = bf2f(av.w);
        Bs0[bk * 64 + bn] = bv0.x; Bs0[bk * 64 + bn + 1] = bv0.y;
        if (NBM == 2) { Bs1[bk * 64 + bn] = bv1.x; Bs1[bk * 64 + bn + 1] = bv1.y; }
        __syncthreads();
#pragma unroll 4
        for (int kk = 0; kk < 16; ++kk) {
            const float4 a4 = *(const float4*)&As[kk * 132 + ty * 4];
            const float4 b4 = *(const float4*)&Bs0[kk * 64 + tx * 4];
            const float a[4] = {a4.x, a4.y, a4.z, a4.w}; const float b[4] = {b4.x, b4.y, b4.z, b4.w};
#pragma unroll
            for (int i = 0; i < 4; ++i)
#pragma unroll
                for (int j = 0; j < 4; ++j) acc[0][i][j] += a[i] * b[j];
            if (NBM == 2) {
                const float4 c4 = *(const float4*)&Bs1[kk * 64 + tx * 4];
                const float c[4] = {c4.x, c4.y, c4.z, c4.w};
#pragma unroll
                for (int i = 0; i < 4; ++i)
#pragma unroll
                    for (int j = 0; j < 4; ++j) acc[1][i][j] += a[i] * c[j];
            }
        }
    }
    __syncthreads();
}
template <int NBM> __device__ __forceinline__ void zero_acc(float (&acc)[NBM][4][4]) {
#pragma unroll
    for (int b = 0; b < NBM; ++b)
#pragma unroll
        for (int i = 0; i < 4; ++i)
#pragma unroll
            for (int j = 0; j < 4; ++j) acc[b][i][j] = 0.f;
}
__device__ __forceinline__ void store_bf4(bf16_t* dst, float a, float b, float c, float d) {
    uint2 v; v.x = (unsigned)f2bf(a) | ((unsigned)f2bf(b) << 16); v.y = (unsigned)f2bf(c) | ((unsigned)f2bf(d) << 16); *(uint2*)dst = v;
}


namespace pg {
#define PG_LAS __attribute__((address_space(3)))
typedef short bf16x8 __attribute__((ext_vector_type(8)));
typedef float f32x4 __attribute__((ext_vector_type(4)));
typedef unsigned u32x4 __attribute__((ext_vector_type(4)));
typedef unsigned u32x2 __attribute__((ext_vector_type(2)));
constexpr int BM = 256, BK = 64, HALF = 128, HTB = HALF * BK * 2, STAGE_BYTES = 8 * HTB;
__device__ __forceinline__ int lds_byte(int r, int c) { const int st = (r >> 4) * 2 + (c >> 5), rr = r & 15, cc = c & 31, ob = rr * 64 + cc * 2; return st * 1024 + (ob ^ (((ob >> 9) & 1) << 5)); }
__device__ __forceinline__ void stage_rc(int b, int& R, int& C) { const int st = b / 1024, sb = b % 1024, swz = sb ^ (((sb >> 9) & 1) << 5); R = (st >> 1) * 16 + swz / 64; C = (st & 1) * 32 + (swz % 64) / 2; }
__device__ __forceinline__ int perm32(int rho) { const int n = rho >> 4, i = rho & 15; return 8 * (i >> 2) + 4 * n + (i & 3); }
__device__ __forceinline__ unsigned cvt_pk_bf16(float lo, float hi) { unsigned r; asm volatile("s_nop 1\n\tv_cvt_pk_bf16_f32 %0, %1, %2" : "=v"(r) : "v"(lo), "v"(hi)); return r; }

struct Unit { const char* a; const char* b; int pm, pn, aux, swap, K, ldb; };

template <bool SWAP, class Epi, class Sched>
__device__ __forceinline__ void gemm_phase(PG_LAS unsigned char* lds, const int K, const Sched& S, const Epi& E, const int tid) {
    const int wid = __builtin_amdgcn_readfirstlane(tid >> 6), lane = tid & 63, wr = wid >> 2, wc = wid & 3, fr = lane & 15, fq = lane >> 4;
    const int nt = K / BK;
    unsigned voffB[2];
#pragma unroll
    for (int i = 0; i < 2; ++i) { int sR, sC; stage_rc(tid * 16 + i * 8192, sR, sC); const int Rb = (sR & ~31) + perm32(sR & 31); voffB[i] = (unsigned)(Rb * S.ldb + sC) * 2u; }
#define PG_AOFF(u_, h_, i_) ([&]() { int sR, sC; stage_rc(tid * 16 + (i_) * 8192, sR, sC); return S.a_off(u_, h_, sR, sC); }())
    const size_t kstep = (size_t)(BK * 2);
    const size_t hstepB = (size_t)HALF * S.ldb * 2;
    const unsigned ldsw = (unsigned)wid * 1024u;
    const int aoff = lds_byte(wr * 64 + fr, fq * 8), boff = lds_byte(wc * 32 + fr, fq * 8);
#define PG_SA(b, h) (((b) * 2 + (h)) * HTB)
#define PG_SB(b, h) ((4 + (b) * 2 + (h)) * HTB)
#define PG_STAGE2(bufoff, gbase, o0, o1) do { \
        __builtin_amdgcn_global_load_lds((const unsigned*)((const char*)(gbase) + (o0)), (PG_LAS unsigned*)(lds + (bufoff) + ldsw), 16, 0, 0); \
        __builtin_amdgcn_global_load_lds((const unsigned*)((const char*)(gbase) + (o1)), (PG_LAS unsigned*)(lds + (bufoff) + ldsw + 8192), 16, 0, 0); } while (0)
#define PG_STAGEB(bufoff, gbase) PG_STAGE2(bufoff, gbase, voffB[0], voffB[1])
#define PG_LDA(dst, b, h) do { _Pragma("unroll") for (int m = 0; m < 4; ++m) _Pragma("unroll") for (int k = 0; k < 2; ++k) dst[m][k] = *(const PG_LAS bf16x8*)(lds + PG_SA(b, h) + aoff + m * 2048 + k * 1024); } while (0)
#define PG_LDB(dst, b, h) do { _Pragma("unroll") for (int n = 0; n < 2; ++n) _Pragma("unroll") for (int k = 0; k < 2; ++k) dst[n][k] = *(const PG_LAS bf16x8*)(lds + PG_SB(b, h) + boff + n * 2048 + k * 1024); } while (0)
#define PG_MMA(ai, bj, At, Bt) do { __builtin_amdgcn_s_setprio(1); \
        if constexpr (SWAP) { _Pragma("unroll") for (int m = 0; m < 4; ++m) _Pragma("unroll") for (int n = 0; n < 2; ++n) _Pragma("unroll") for (int k = 0; k < 2; ++k) \
            acc[ai][bj][m][n] = __builtin_amdgcn_mfma_f32_16x16x32_bf16(At[m][k], Bt[n][k], acc[ai][bj][m][n], 0, 0, 0); } \
        else { _Pragma("unroll") for (int m = 0; m < 4; ++m) _Pragma("unroll") for (int n = 0; n < 2; ++n) _Pragma("unroll") for (int k = 0; k < 2; ++k) \
            acc[ai][bj][m][n] = __builtin_amdgcn_mfma_f32_16x16x32_bf16(Bt[n][k], At[m][k], acc[ai][bj][m][n], 0, 0, 0); } \
        __builtin_amdgcn_s_setprio(0); } while (0)
#define PG_WAIT_V(n) asm volatile("s_waitcnt vmcnt(" #n ")" ::: "memory")
#define PG_WAIT_L(n) asm volatile("s_waitcnt lgkmcnt(" #n ")" ::: "memory")
#define PG_BAR __builtin_amdgcn_s_barrier()
#define PG_SCHED __builtin_amdgcn_sched_barrier(0)
    Unit cur, nxt; int ui = 0;
    if (!S.next(0, cur)) return;
    f32x4 acc[2][2][4][2];
#pragma unroll
    for (int a = 0; a < 2; ++a)
#pragma unroll
        for (int b = 0; b < 2; ++b)
#pragma unroll
            for (int m = 0; m < 4; ++m)
#pragma unroll
                for (int n = 0; n < 2; ++n) acc[a][b][m][n] = (f32x4){0.f, 0.f, 0.f, 0.f};
    bf16x8 At[4][2], B0[2][2], B1[2][2];
    unsigned c00 = PG_AOFF(cur, 0, 0), c01 = PG_AOFF(cur, 0, 1), c10 = PG_AOFF(cur, 1, 0), c11 = PG_AOFF(cur, 1, 1);
    const char* cA = cur.a; const char* cB = cur.b;
    PG_STAGEB(PG_SB(0, 0), cB); PG_STAGEB(PG_SB(0, 1), cB + hstepB); PG_STAGE2(PG_SA(0, 0), cA, c00, c01); PG_STAGE2(PG_SA(0, 1), cA, c10, c11);
    if (wr == 1) PG_BAR;
    PG_WAIT_V(2); PG_BAR;
    PG_STAGEB(PG_SB(1, 0), cB + kstep); PG_STAGE2(PG_SA(1, 0), cA + kstep, c00, c01); PG_STAGEB(PG_SB(1, 1), cB + hstepB + kstep);
    PG_WAIT_V(6); PG_BAR;
    for (;;) {
        const bool has_next = S.next(ui + 1, nxt);
        const char* nA = has_next ? nxt.a : cA; const char* nB = has_next ? nxt.b : cB;
#pragma unroll 1
        for (int t = 0; t < nt; t += 2) {
            const bool last = (t == nt - 2);
            if constexpr (Epi::MID) { if (t == 8 || t == 16) { int fr_ = fr, fq_ = fq; asm volatile("" : "+v"(fr_), "+v"(fq_)); E.mid(acc, cur, t, wr, wc, fr_, fq_); } }
            const char* a1 = cA + (size_t)(t + 1) * kstep;
            const char* a2 = last ? nA : cA + (size_t)(t + 2) * kstep; const char* b2 = last ? nB : cB + (size_t)(t + 2) * kstep;
            const char* a3 = a2 + kstep; const char* b3 = b2 + kstep;
            PG_LDB(B0, 0, 0); PG_LDB(B1, 0, 1); PG_SCHED; PG_LDA(At, 0, 0); PG_STAGE2(PG_SA(1, 1), a1, c10, c11);
            if (last && has_next) { c00 = PG_AOFF(nxt, 0, 0); c01 = PG_AOFF(nxt, 0, 1); c10 = PG_AOFF(nxt, 1, 0); c11 = PG_AOFF(nxt, 1, 1); }
            PG_WAIT_V(8); PG_WAIT_L(0); PG_BAR; PG_MMA(0, 0, At, B0); PG_MMA(0, 1, At, B1); PG_BAR; PG_SCHED;
            PG_LDA(At, 0, 1); PG_STAGEB(PG_SB(0, 0), b2); PG_STAGEB(PG_SB(0, 1), b2 + hstepB); PG_STAGE2(PG_SA(0, 0), a2, c00, c01);
            PG_WAIT_V(8); PG_WAIT_L(0); PG_BAR; PG_MMA(1, 0, At, B0); PG_MMA(1, 1, At, B1); PG_BAR; PG_SCHED;
            PG_LDB(B0, 1, 0); PG_LDB(B1, 1, 1); PG_SCHED; PG_LDA(At, 1, 0); PG_STAGE2(PG_SA(0, 1), a2, c10, c11);
            PG_WAIT_V(8); PG_WAIT_L(0); PG_BAR; PG_MMA(0, 0, At, B0); PG_MMA(0, 1, At, B1); PG_BAR; PG_SCHED;
            PG_LDA(At, 1, 1); PG_STAGEB(PG_SB(1, 0), b3); PG_STAGEB(PG_SB(1, 1), b3 + hstepB); PG_STAGE2(PG_SA(1, 0), a3, c00, c01);
            PG_WAIT_V(8); PG_WAIT_L(0); PG_BAR; PG_MMA(1, 0, At, B0); PG_MMA(1, 1, At, B1); PG_BAR; PG_SCHED;
        }
        if (wr == 0) PG_BAR;
        { int fr_ = fr, fq_ = fq, wr_ = wr, wc_ = wc; asm volatile("" : "+v"(fr_), "+v"(fq_), "+s"(wr_), "+s"(wc_));
          E(acc, cur, wr_, wc_, fr_, fq_); }
        if (!has_next) break;
#pragma unroll
        for (int a = 0; a < 2; ++a)
#pragma unroll
            for (int b = 0; b < 2; ++b)
#pragma unroll
                for (int m = 0; m < 4; ++m)
#pragma unroll
                    for (int n = 0; n < 2; ++n) acc[a][b][m][n] = (f32x4){0.f, 0.f, 0.f, 0.f};
        cur = nxt; cA = nA; cB = nB; ++ui;
        if (wr == 1) PG_BAR;
    }
    PG_WAIT_V(0);
    PG_BAR;
#undef PG_AOFF
#undef PG_SA
#undef PG_SB
#undef PG_STAGE2
#undef PG_STAGEB
#undef PG_LDA
#undef PG_LDB
#undef PG_MMA
#undef PG_WAIT_V
#undef PG_WAIT_L
#undef PG_BAR
#undef PG_SCHED
}

template <class Epi, class Sched>
__device__ __forceinline__ void gemm_phase_var(PG_LAS unsigned char* lds, const Sched& S, const Epi& E, const int tid) {
    constexpr bool SWAP = false;
    const int wid = __builtin_amdgcn_readfirstlane(tid >> 6), wr = wid >> 2, wc = wid & 3;
#define PG_BOFF(ldb_, i_) ([&]() { int sR, sC; stage_rc(tid * 16 + (i_) * 8192, sR, sC); const int Rb = (sR & ~31) + perm32(sR & 31); return (unsigned)(Rb * (ldb_) + sC) * 2u; }())
#define PG_AOFF(u_, h_, i_) ([&]() { int sR, sC; stage_rc(tid * 16 + (i_) * 8192, sR, sC); return S.a_off(u_, h_, sR, sC); }())
    const size_t kstep = (size_t)(BK * 2);
    const unsigned ldsw = (unsigned)wid * 1024u;
    const int aoff = lds_byte(wr * 64 + (tid & 15), ((tid & 63) >> 4) * 8), boff = lds_byte(wc * 32 + (tid & 15), ((tid & 63) >> 4) * 8);
#define PG_SA(b, h) (((b) * 2 + (h)) * HTB)
#define PG_SB(b, h) ((4 + (b) * 2 + (h)) * HTB)
#define PG_STAGE2(bufoff, gbase, o0, o1) do { \
        __builtin_amdgcn_global_load_lds((const unsigned*)((const char*)(gbase) + (o0)), (PG_LAS unsigned*)(lds + (bufoff) + ldsw), 16, 0, 0); \
        __builtin_amdgcn_global_load_lds((const unsigned*)((const char*)(gbase) + (o1)), (PG_LAS unsigned*)(lds + (bufoff) + ldsw + 8192), 16, 0, 0); } while (0)
#define PG_STAGEB(bufoff, gbase) PG_STAGE2(bufoff, gbase, vB0, vB1)
#define PG_LDA(dst, b, h) do { _Pragma("unroll") for (int m = 0; m < 4; ++m) _Pragma("unroll") for (int k = 0; k < 2; ++k) dst[m][k] = *(const PG_LAS bf16x8*)(lds + PG_SA(b, h) + aoff + m * 2048 + k * 1024); } while (0)
#define PG_LDB(dst, b, h) do { _Pragma("unroll") for (int n = 0; n < 2; ++n) _Pragma("unroll") for (int k = 0; k < 2; ++k) dst[n][k] = *(const PG_LAS bf16x8*)(lds + PG_SB(b, h) + boff + n * 2048 + k * 1024); } while (0)
#define PG_MMA(ai, bj, At, Bt) do { __builtin_amdgcn_s_setprio(1); \
        if constexpr (SWAP) { _Pragma("unroll") for (int m = 0; m < 4; ++m) _Pragma("unroll") for (int n = 0; n < 2; ++n) _Pragma("unroll") for (int k = 0; k < 2; ++k) \
            acc[ai][bj][m][n] = __builtin_amdgcn_mfma_f32_16x16x32_bf16(At[m][k], Bt[n][k], acc[ai][bj][m][n], 0, 0, 0); } \
        else { _Pragma("unroll") for (int m = 0; m < 4; ++m) _Pragma("unroll") for (int n = 0; n < 2; ++n) _Pragma("unroll") for (int k = 0; k < 2; ++k) \
            acc[ai][bj][m][n] = __builtin_amdgcn_mfma_f32_16x16x32_bf16(Bt[n][k], At[m][k], acc[ai][bj][m][n], 0, 0, 0); } \
        __builtin_amdgcn_s_setprio(0); } while (0)
#define PG_WAIT_V(n) asm volatile("s_waitcnt vmcnt(" #n ")" ::: "memory")
#define PG_WAIT_L(n) asm volatile("s_waitcnt lgkmcnt(" #n ")" ::: "memory")
#define PG_BAR __builtin_amdgcn_s_barrier()
#define PG_SCHED __builtin_amdgcn_sched_barrier(0)
    Unit cur, nxt; int ui = 0;
    if (!S.next(0, cur)) return;
    int nt = cur.K / BK; unsigned vB0 = PG_BOFF(cur.ldb, 0), vB1 = PG_BOFF(cur.ldb, 1); size_t hstepB = (size_t)HALF * cur.ldb * 2;
    f32x4 acc[2][2][4][2];
#pragma unroll
    for (int a = 0; a < 2; ++a)
#pragma unroll
        for (int b = 0; b < 2; ++b)
#pragma unroll
            for (int m = 0; m < 4; ++m)
#pragma unroll
                for (int n = 0; n < 2; ++n) acc[a][b][m][n] = (f32x4){0.f, 0.f, 0.f, 0.f};
    bf16x8 At[4][2], B0[2][2], B1[2][2];
    unsigned c00 = PG_AOFF(cur, 0, 0), c01 = PG_AOFF(cur, 0, 1), c10 = PG_AOFF(cur, 1, 0), c11 = PG_AOFF(cur, 1, 1);
    const char* cA = cur.a; const char* cB = cur.b;
    PG_STAGEB(PG_SB(0, 0), cB); PG_STAGEB(PG_SB(0, 1), cB + hstepB); PG_STAGE2(PG_SA(0, 0), cA, c00, c01); PG_STAGE2(PG_SA(0, 1), cA, c10, c11);
    if (wr == 1) PG_BAR;
    PG_WAIT_V(2); PG_BAR;
    PG_STAGEB(PG_SB(1, 0), cB + kstep); PG_STAGE2(PG_SA(1, 0), cA + kstep, c00, c01); PG_STAGEB(PG_SB(1, 1), cB + hstepB + kstep);
    PG_WAIT_V(6); PG_BAR;
    for (;;) {
        const bool has_next = S.next(ui + 1, nxt);
        const bool dep = has_next && S.defer(nxt);
        bool pre = has_next && !dep;
        const char* nA = pre ? nxt.a : cA; const char* nB = pre ? nxt.b : cB;
#pragma unroll 1
        for (int t = 0; t < nt; t += 2) {
            const bool last = (t == nt - 2);
            if constexpr (Epi::MID) { if ((t == 8 || t == 16) && E.has_mid(cur)) { int fr_ = tid & 15, fq_ = (tid & 63) >> 4; asm volatile("" : "+v"(fr_), "+v"(fq_)); E.mid(acc, cur, t, wr, wc, fr_, fq_); } }
            if (last && dep) {
                volatile PG_LAS int* flag = (volatile PG_LAS int*)(lds + 8 * HTB + 4096);
                if (tid < 64) { const bool ok = S.try_ready(nxt); if (tid == 0) *flag = ok ? 1 : 0; PG_WAIT_L(0); }
                asm volatile("" ::: "memory"); PG_BAR; asm volatile("" ::: "memory");
                pre = __builtin_amdgcn_readfirstlane(*flag) != 0;
                if (pre) { nA = nxt.a; nB = nxt.b; }
            }
            const char* a1 = cA + (size_t)(t + 1) * kstep;
            const char* a2 = last ? nA : cA + (size_t)(t + 2) * kstep; const char* b2 = last ? nB : cB + (size_t)(t + 2) * kstep;
            const char* a3 = a2 + kstep; const char* b3 = b2 + kstep;
            PG_LDB(B0, 0, 0); PG_LDB(B1, 0, 1); PG_SCHED; PG_LDA(At, 0, 0); PG_STAGE2(PG_SA(1, 1), a1, c10, c11);
            if (last && pre) { c00 = PG_AOFF(nxt, 0, 0); c01 = PG_AOFF(nxt, 0, 1);
                                    vB0 = PG_BOFF(nxt.ldb, 0); vB1 = PG_BOFF(nxt.ldb, 1); hstepB = (size_t)HALF * nxt.ldb * 2; }
            PG_WAIT_V(8); PG_WAIT_L(0); PG_BAR; PG_MMA(0, 0, At, B0); PG_MMA(0, 1, At, B1); PG_BAR; PG_SCHED;
            PG_LDA(At, 0, 1); PG_STAGEB(PG_SB(0, 0), b2); PG_STAGEB(PG_SB(0, 1), b2 + hstepB); PG_STAGE2(PG_SA(0, 0), a2, c00, c01);
            if (last && pre) { c10 = PG_AOFF(nxt, 1, 0); c11 = PG_AOFF(nxt, 1, 1); }
            PG_WAIT_V(8); PG_WAIT_L(0); PG_BAR; PG_MMA(1, 0, At, B0); PG_MMA(1, 1, At, B1); PG_BAR; PG_SCHED;
            PG_LDB(B0, 1, 0); PG_LDB(B1, 1, 1); PG_SCHED; PG_LDA(At, 1, 0); PG_STAGE2(PG_SA(0, 1), a2, c10, c11);
            PG_WAIT_V(8); PG_WAIT_L(0); PG_BAR; PG_MMA(0, 0, At, B0); PG_MMA(0, 1, At, B1); PG_BAR; PG_SCHED;
            PG_LDA(At, 1, 1); PG_STAGEB(PG_SB(1, 0), b3); PG_STAGEB(PG_SB(1, 1), b3 + hstepB); PG_STAGE2(PG_SA(1, 0), a3, c00, c01);
            PG_WAIT_V(8); PG_WAIT_L(0); PG_BAR; PG_MMA(1, 0, At, B0); PG_MMA(1, 1, At, B1); PG_BAR; PG_SCHED;
        }
        if (wr == 0) PG_BAR;
        { int fr_ = tid & 15, fq_ = (tid & 63) >> 4, wr_ = wr, wc_ = wc; asm volatile("" : "+v"(fr_), "+v"(fq_), "+s"(wr_), "+s"(wc_));
          E(acc, cur, wr_, wc_, fr_, fq_); }
        S.publish(cur, tid);
        if (!has_next) break;
#pragma unroll
        for (int a = 0; a < 2; ++a)
#pragma unroll
            for (int b = 0; b < 2; ++b)
#pragma unroll
                for (int m = 0; m < 4; ++m)
#pragma unroll
                    for (int n = 0; n < 2; ++n) acc[a][b][m][n] = (f32x4){0.f, 0.f, 0.f, 0.f};
        cur = nxt; cA = cur.a; cB = cur.b; ++ui; nt = cur.K / BK;
        if (pre) { if (wr == 1) PG_BAR; }
        else {
            PG_WAIT_V(0);
            S.wait_ready(cur, tid);
            c00 = PG_AOFF(cur, 0, 0); c01 = PG_AOFF(cur, 0, 1); c10 = PG_AOFF(cur, 1, 0); c11 = PG_AOFF(cur, 1, 1);
            vB0 = PG_BOFF(cur.ldb, 0); vB1 = PG_BOFF(cur.ldb, 1); hstepB = (size_t)HALF * cur.ldb * 2;
            PG_STAGEB(PG_SB(0, 0), cB); PG_STAGEB(PG_SB(0, 1), cB + hstepB); PG_STAGE2(PG_SA(0, 0), cA, c00, c01); PG_STAGE2(PG_SA(0, 1), cA, c10, c11);
            if (wr == 1) PG_BAR;
            PG_WAIT_V(2); PG_BAR;
            PG_STAGEB(PG_SB(1, 0), cB + kstep); PG_STAGE2(PG_SA(1, 0), cA + kstep, c00, c01); PG_STAGEB(PG_SB(1, 1), cB + hstepB + kstep);
            PG_WAIT_V(6); PG_BAR;
        }
    }
    PG_WAIT_V(0);
    PG_BAR;
#undef PG_AOFF
#undef PG_BOFF
#undef PG_SA
#undef PG_SB
#undef PG_STAGE2
#undef PG_STAGEB
#undef PG_LDA
#undef PG_LDB
#undef PG_MMA
#undef PG_WAIT_V
#undef PG_WAIT_L
#undef PG_BAR
#undef PG_SCHED
}

__device__ __forceinline__ void static_tile(int L, int nM, int nN, int& pm, int& pn) {
    const int nwg = nM * nN, NX = 8, WGM = 8;
    int wgid = L; { const int q = nwg / NX, r = nwg % NX, xcd = wgid % NX, off = wgid / NX; wgid = (xcd < r ? xcd * (q + 1) : r * (q + 1) + (xcd - r) * q) + off; }
    const int nig = WGM * nN, gid = wgid / nig, fm = gid * WGM, gsz = (nM - fm) < WGM ? (nM - fm) : WGM;
    pm = fm + ((wgid % nig) % gsz); pn = (wgid % nig) / gsz;
}
}

__device__ __forceinline__ pg::u32x4 pack8(const pg::f32x4& v0, const pg::f32x4& v1) {
    pg::u32x4 w; w.x = pg::cvt_pk_bf16(v0[0], v0[1]); w.y = pg::cvt_pk_bf16(v0[2], v0[3]); w.z = pg::cvt_pk_bf16(v1[0], v1[1]); w.w = pg::cvt_pk_bf16(v1[2], v1[3]); return w;
}
__device__ __forceinline__ void unpack8(const pg::u32x4& w, float (&f)[8]) {
    f[0] = __uint_as_float(w.x << 16); f[1] = __uint_as_float(w.x & 0xffff0000u); f[2] = __uint_as_float(w.y << 16); f[3] = __uint_as_float(w.y & 0xffff0000u);
    f[4] = __uint_as_float(w.z << 16); f[5] = __uint_as_float(w.z & 0xffff0000u); f[6] = __uint_as_float(w.w << 16); f[7] = __uint_as_float(w.w & 0xffff0000u);
}

struct ConvTile { const float* src; bf16_t* dst; int N, ldd, mode; };
__device__ __forceinline__ void conv_load(const ConvTile& t, float4 (&v)[8], int tid) {
    const int kk = tid >> 4, n4 = (tid & 15) * 4;
#pragma unroll
    for (int i = 0; i < 8; ++i) v[i] = *(const float4*)(t.src + (size_t)(kk * 8 + i) * t.N + n4);
}
__device__ __forceinline__ void conv_store(const ConvTile& t, const float4 (&v)[8], float* sm, int tid) {
    bf16_t* tile = (bf16_t*)sm;
    const int kk = tid >> 4, n4 = (tid & 15) * 4;
    __syncthreads();
    {
        const int pos = (kk ^ ((n4 >> 2) & 7)) * 8;
        uint4 w;
        w.x = (unsigned)f2bf(v[0].x) | ((unsigned)f2bf(v[1].x) << 16); w.y = (unsigned)f2bf(v[2].x) | ((unsigned)f2bf(v[3].x) << 16); w.z = (unsigned)f2bf(v[4].x) | ((unsigned)f2bf(v[5].x) << 16); w.w = (unsigned)f2bf(v[6].x) | ((unsigned)f2bf(v[7].x) << 16);
        *(uint4*)(tile + (n4 + 0) * 264 + pos) = w;
        w.x = (unsigned)f2bf(v[0].y) | ((unsigned)f2bf(v[1].y) << 16); w.y = (unsigned)f2bf(v[2].y) | ((unsigned)f2bf(v[3].y) << 16); w.z = (unsigned)f2bf(v[4].y) | ((unsigned)f2bf(v[5].y) << 16); w.w = (unsigned)f2bf(v[6].y) | ((unsigned)f2bf(v[7].y) << 16);
        *(uint4*)(tile + (n4 + 1) * 264 + pos) = w;
        w.x = (unsigned)f2bf(v[0].z) | ((unsigned)f2bf(v[1].z) << 16); w.y = (unsigned)f2bf(v[2].z) | ((unsigned)f2bf(v[3].z) << 16); w.z = (unsigned)f2bf(v[4].z) | ((unsigned)f2bf(v[5].z) << 16); w.w = (unsigned)f2bf(v[6].z) | ((unsigned)f2bf(v[7].z) << 16);
        *(uint4*)(tile + (n4 + 2) * 264 + pos) = w;
        w.x = (unsigned)f2bf(v[0].w) | ((unsigned)f2bf(v[1].w) << 16); w.y = (unsigned)f2bf(v[2].w) | ((unsigned)f2bf(v[3].w) << 16); w.z = (unsigned)f2bf(v[4].w) | ((unsigned)f2bf(v[5].w) << 16); w.w = (unsigned)f2bf(v[6].w) | ((unsigned)f2bf(v[7].w) << 16);
        *(uint4*)(tile + (n4 + 3) * 264 + pos) = w;
    }
    __syncthreads();
#pragma unroll
    for (int i = 0; i < 4; ++i) {
        const int e = tid + i * NT, nn = e >> 5, kc = e & 31;
        const int row = t.mode == 0 ? nn : ((t.mode == 2 ? 128 : 0) + nn);
        *(uint4*)(t.dst + (size_t)row * t.ldd + kc * 8) = *(const uint4*)(tile + nn * 264 + (kc ^ ((nn >> 2) & 7)) * 8);
    }
}

__device__ __forceinline__ float posemb(int pos, int dd) {
    const int i = dd & 255;
    const float omega = 1.0f / powf(10000.0f, (float)i / 256.0f);
    const float ang = (float)pos * omega;
    return dd < 256 ? sinf(ang) : cosf(ang);
}
struct HyFiltW { float w1[33]; float w2[64]; float b1, b2, f0, f1; };
__device__ __forceinline__ void hy_filter_load(const Ctx& c, int l, HyFiltW& W) {
    const float* w1 = c.p->in[I_HYW1] + (size_t)l * 33 * 64; const float* w2 = c.p->in[I_HYW2] + (size_t)l * 64 * 64;
#pragma unroll
    for (int i = 0; i < 33; ++i) W.w1[i] = w1[i * 64 + c.lane];
#pragma unroll
    for (int i = 0; i < 64; ++i) W.w2[i] = w2[i * 64 + c.lane];
    W.b1 = c.p->in[I_HYB1][l * 64 + c.lane]; W.b2 = c.p->in[I_HYB2][l * 64 + c.lane];
    W.f0 = c.p->in[I_HYFREQ][(l * 2 + 0) * 64 + c.lane]; W.f1 = c.p->in[I_HYFREQ][(l * 2 + 1) * 64 + c.lane];
}
__device__ __forceinline__ void hy_filter_item(const Ctx& c, const HyFiltW& W, int ntok, int t, bf16_t* dst, int dstride, int doff, const float* w3s) {
    const int lane = c.lane;
    const float tt = (float)t / (float)(ntok - 1);
    const float w = 6.283185307179586f * (float)t / (float)ntok;
    float a = W.b1 + tt * W.w1[0];
#pragma unroll
    for (int j = 0; j < 16; ++j) {
        const float f = 1e-4f + (float)j * ((15.0f - 1e-4f) / 15.0f);
        const float ang = f * w;
        a += __cosf(ang) * W.w1[1 + j];
        a += -__sinf(ang) * W.w1[17 + j];
    }
    const float h1 = __sinf(W.f0 * a);
    float a2 = W.b2;
#pragma unroll
    for (int i = 0; i < 64; ++i) a2 += __int_as_float(__builtin_amdgcn_readlane(__float_as_int(h1), i)) * W.w2[i];
    const float h2 = __sinf(W.f1 * a2);
    float acc[8];
#pragma unroll
    for (int m = 0; m < 8; ++m) acc[m] = 0.f;
#pragma unroll 4
    for (int j = 0; j < 64; ++j) {
        const float hj = __int_as_float(__builtin_amdgcn_readlane(__float_as_int(h2), j));
#pragma unroll
        for (int m = 0; m < 8; ++m) acc[m] += hj * w3s[j * 512 + m * 64 + lane];
    }
    const float offset = fabsf((float)(t - ntok / 2)) / (float)ntok;
    const float lo = logf(1e-2f) / 1.5f, hi = logf(1e-2f) / 0.3f;
#pragma unroll
    for (int m = 0; m < 8; ++m) {
        const int ch = m * 64 + lane;
        const float delta = fabsf(lo + (float)ch * ((hi - lo) / 511.0f));
        dst[(size_t)ch * dstride + doff] = f2bf(acc[m] * expf(-offset * delta));
    }
}
__device__ __forceinline__ void s5_param_item(const Ctx& c, int l, int g);
__device__ __forceinline__ void phase_init(const Ctx& c) {
    const int gtid = c.bid * NT + c.tid, gthreads = c.nblk * NT;
    for (int idx = gtid; idx < 64 * 512; idx += gthreads) cPET(c)[idx] = posemb(idx >> 9, idx & 511);
    {
        float* s = c.smem;
        float* red = c.smem + 5 * 1024;
        __syncthreads();
        for (int i = c.tid; i < 5 * 1024; i += NT) { const float v = (i < 4096) ? c.p->in[I_C][i] : c.p->in[I_CCTX][i - 4096]; s[i] = siluf_(v); }
        __syncthreads();
#pragma unroll 1
        for (int it = c.bid; it < 256; it += c.nblk) {
            const int l = it >> 7, n0 = (it & 127) * 48;
            const int c4 = c.tid % 12, kg = c.tid / 12;
            if (kg < 40) {
                float acc[5][4];
#pragma unroll
                for (int i = 0; i < 5; ++i)
#pragma unroll
                    for (int j = 0; j < 4; ++j) acc[i][j] = 0.f;
                const float* wm = c.p->in[I_WMOD] + (size_t)l * 1024 * 6144 + n0 + c4 * 4;
#pragma unroll 1
                for (int hb = 0; hb < 2; ++hb) {
                    float4 w[13];
#pragma unroll
                    for (int q = 0; q < 13; ++q) { const int k = kg + 40 * (hb * 13 + q); w[q] = k < 1024 ? *(const float4*)(wm + (size_t)k * 6144) : make_float4(0.f, 0.f, 0.f, 0.f); }
#pragma unroll
                    for (int q = 0; q < 13; ++q) {
                        const int k = kg + 40 * (hb * 13 + q);
                        if (k < 1024) {
#pragma unroll
                            for (int i = 0; i < 5; ++i) { const float sv = s[i * 1024 + k]; acc[i][0] += sv * w[q].x; acc[i][1] += sv * w[q].y; acc[i][2] += sv * w[q].z; acc[i][3] += sv * w[q].w; }
                        }
                    }
                }
#pragma unroll
                for (int i = 0; i < 5; ++i)
#pragma unroll
                    for (int j = 0; j < 4; ++j) red[(kg * 48 + c4 * 4 + j) * 5 + i] = acc[i][j];
            }
            __syncthreads();
            if (c.tid < 240) {
                const int cl = c.tid / 5, i = c.tid % 5;
                float t = c.p->in[I_BMOD][l * 6144 + n0 + cl];
#pragma unroll 8
                for (int q = 0; q < 40; ++q) t += red[(q * 48 + cl) * 5 + i];
                cMOD(c)[(l * 5 + i) * 6144 + n0 + cl] = t;
            }
            __syncthreads();
        }
    }
    if (c.bid >= 64) {
        float* w3s = c.smem;
        bf16_t* stg = (bf16_t*)(c.smem + 64 * 512);
        const int rank = c.bid - 64, nrank = c.nblk - 64;
#pragma unroll 1
        for (int l = 0; l < 2; ++l) {
            HyFiltW W; hy_filter_load(c, l, W);
            __syncthreads();
            { const float* w3 = c.p->in[I_HYW3] + (size_t)l * 64 * 512; for (int i = c.tid; i < 64 * 512 / 4; i += NT) ((float4*)w3s)[i] = ((const float4*)w3)[i]; }
            __syncthreads();
            const int nit = (l == 0) ? (L + LC) / 8 : L / 8;
#pragma unroll 1
            for (int it = rank; it < nit; it += nrank) {
                int ntok, t0; bf16_t* dst;
                if (it < L / 8) { t0 = it * 8; ntok = L; dst = cFILT(c) + (size_t)l * 512 * L; }
                else { t0 = (it - L / 8) * 8; ntok = LC; dst = cFILTC(c); }
                hy_filter_item(c, W, ntok, t0 + c.wave, stg + c.wave, 8, 0, w3s);
                __syncthreads();
                *(uint4*)(dst + (size_t)c.tid * ntok + t0) = *(const uint4*)(stg + c.tid * 8);
                __syncthreads();
            }
        }
    }
#pragma unroll 1
    for (int it = c.bid; it < 64; it += c.nblk) s5_param_item(c, it >> 5, it & 31);
}

__device__ __forceinline__ void norm_apply(const Ctx& c, int l, int r, int which, float (&y)[16]) {
    const float* mod = cMOD(c) + (size_t)(l * 5 + (r < RL ? r / L : 4)) * 6144 + (which ? 3072 : 0);
    const float* g = c.p->in[which ? I_N2G : I_N1G] + l * D;
    float ss = 0.f;
#pragma unroll
    for (int i = 0; i < 16; ++i) ss += y[i] * y[i];
    ss = wave_sum(ss, c.lane);
    const float rinv = rsqrtf(ss * (1.0f / 1024.0f) + 1e-6f);
#pragma unroll
    for (int j = 0; j < 4; ++j) {
        const int d = (j * 64 + c.lane) * 4;
        const float4 gg = *(const float4*)(g + d), sh = *(const float4*)(mod + d), sc = *(const float4*)(mod + 1024 + d);
        y[j * 4 + 0] = y[j * 4 + 0] * rinv * gg.x * (1.f + sc.x) + sh.x;
        y[j * 4 + 1] = y[j * 4 + 1] * rinv * gg.y * (1.f + sc.y) + sh.y;
        y[j * 4 + 2] = y[j * 4 + 2] * rinv * gg.z * (1.f + sc.z) + sh.z;
        y[j * 4 + 3] = y[j * 4 + 3] * rinv * gg.w * (1.f + sc.w) + sh.w;
    }
}
__device__ __forceinline__ void norm_row(const Ctx& c, int l, int r, int which, float (&y)[16]) {
    const float* src = r < RL ? c.X + (size_t)r * D : cXC(c) + (size_t)(r - RL) * D;
#pragma unroll
    for (int j = 0; j < 4; ++j) {
        const float4 v = *(const float4*)(src + (j * 64 + c.lane) * 4);
        y[j * 4 + 0] = v.x; y[j * 4 + 1] = v.y; y[j * 4 + 2] = v.z; y[j * 4 + 3] = v.w;
    }
    norm_apply(c, l, r, which, y);
}
__device__ __forceinline__ ConvTile conv_desc(const Ctx& c, int l, int it) {
    ConvTile t; int r = it;
    if (r < 448) { const int k0 = (r / 112) * 256, n0 = (r % 112) * 64; t.N = INC; t.ldd = 1024; t.mode = 0; t.src = c.p->in[I_WIN] + (size_t)l * D * INC + (size_t)k0 * INC + n0; t.dst = cWINT(c) + (size_t)n0 * 1024 + k0; return t; }
    r -= 448;
    if (r < 32) { const int w = r >> 4, q = r & 15, k0 = (q >> 3) * 256, n0 = (q & 7) * 64; t.N = 512; t.ldd = 512; t.mode = 1 + w;
        t.src = c.p->in[w ? I_GLU2 : I_GLU1] + (size_t)l * 512 * 512 + (size_t)k0 * 512 + n0; t.dst = cGLUT(c) + (size_t)((n0 >> 7) * 256 + (n0 & 127)) * 512 + k0; return t; }
    r -= 32;
    if (r < 96) { const int nb = r >> 5, q = r & 31, k0 = (q >> 4) * 256, n0 = (q & 15) * 64; t.N = 1024; t.ldd = 1536; t.mode = 0;
        t.src = c.p->in[I_WBR] + (size_t)(l * 3 + nb) * 512 * 1024 + (size_t)k0 * 1024 + n0; t.dst = cBRT(c) + (size_t)n0 * 1536 + nb * 512 + k0; return t; }
    r -= 96;
    if (r < 64) { const int k0 = (r >> 4) * 256, n0 = (r & 15) * 64; t.N = 1024; t.ldd = 1024; t.mode = 0; t.src = c.p->in[I_WOUT] + (size_t)l * 1024 * 1024 + (size_t)k0 * 1024 + n0; t.dst = cOUTT(c) + (size_t)n0 * 1024 + k0; return t; }
    r -= 64;
    if (r < 2048) { const int w = r >> 10, e = (r >> 5) & 31, q = r & 31, k0 = (q >> 3) * 256, n0 = (q & 7) * 64; t.N = 512; t.ldd = 1024; t.mode = 1 + w;
        t.src = c.p->in[w ? I_MW3 : I_MW1] + (size_t)(l * 32 + e) * 1024 * 512 + (size_t)k0 * 512 + n0; t.dst = cUPT(c) + (size_t)e * 1024 * 1024 + (size_t)((n0 >> 7) * 256 + (n0 & 127)) * 1024 + k0; return t; }
    r -= 2048;
    { const int e = r >> 5, q = r & 31, k0 = (q >> 4) * 256, n0 = (q & 15) * 64; t.N = 1024; t.ldd = 512; t.mode = 0;
      t.src = c.p->in[I_MW2] + (size_t)(l * 32 + e) * 512 * 1024 + (size_t)k0 * 1024 + n0; t.dst = cDNT(c) + (size_t)e * 1024 * 512 + (size_t)n0 * 512 + k0; return t; }
}
__device__ __forceinline__ void phase_convert(const Ctx& c, int l, const bool moe, int rank = -1, int nrank = 0) {
    if (rank < 0) { rank = c.bid; nrank = c.nblk; }
    const int first = rank + (moe ? 640 : 0), end = moe ? 3712 : 640;
    if (first >= end) return;
    float4 v[8];
    ConvTile cur = conv_desc(c, l, first);
    conv_load(cur, v, c.tid);
#pragma unroll 1
    for (int it = first; it < end; it += nrank) {
        float4 w[8];
        const int nx = it + nrank;
        ConvTile nxt = cur;
        if (nx < end) { nxt = conv_desc(c, l, nx); conv_load(nxt, w, c.tid); }
        conv_store(cur, v, c.smem, c.tid);
        cur = nxt;
#pragma unroll
        for (int i = 0; i < 8; ++i) v[i] = w[i];
    }
}
__device__ __forceinline__ void phase_norm1(const Ctx& c, int l) {
    phase_convert(c, l, false);
    const int gw = c.bid * 8 + c.wave, nw = c.nblk * 8;
    for (int r = gw; r < R; r += nw) {
        float y[16];
        if (r < RL) {
            const int t = r & (L - 1);
            const float* xs = c.p->in[I_X] + (size_t)r * D;
            const float* per = cPET(c) + (t >> 6) * 512; const float* pec = cPET(c) + (t & 63) * 512;
#pragma unroll
            for (int j = 0; j < 4; ++j) {
                const int d = (j * 64 + c.lane) * 4;
                const float4 xv = *(const float4*)(xs + d);
                const float4 pv = d < 512 ? *(const float4*)(per + d) : *(const float4*)(pec + d - 512);
                y[j * 4] = xv.x + pv.x; y[j * 4 + 1] = xv.y + pv.y; y[j * 4 + 2] = xv.z + pv.z; y[j * 4 + 3] = xv.w + pv.w;
                *(float4*)(c.X + (size_t)r * D + d) = make_float4(y[j * 4], y[j * 4 + 1], y[j * 4 + 2], y[j * 4 + 3]);
            }
        } else {
            const float* xs = c.p->in[I_CTX] + (size_t)(r - RL) * D;
#pragma unroll
            for (int j = 0; j < 4; ++j) {
                const int d = (j * 64 + c.lane) * 4;
                const float4 xv = *(const float4*)(xs + d);
                y[j * 4] = xv.x; y[j * 4 + 1] = xv.y; y[j * 4 + 2] = xv.z; y[j * 4 + 3] = xv.w;
                *(float4*)(cXC(c) + (size_t)(r - RL) * D + d) = xv;
            }
        }
        norm_apply(c, l, r, 0, y);
#pragma unroll
        for (int j = 0; j < 4; ++j) store_bf4(cH(c) + (size_t)r * D + (j * 64 + c.lane) * 4, y[j * 4], y[j * 4 + 1], y[j * 4 + 2], y[j * 4 + 3]);
    }
}
__device__ __forceinline__ void phase_norm2_route(const Ctx& c, int l) {
    PG_LAS unsigned char* lds = (PG_LAS unsigned char*)c.smem;
    constexpr int HP = 1032 * 2;
    constexpr int O_LO = 16 * HP, O_PART = 2 * 16 * HP, O_LG = O_PART + 8 * 3 * 64 * 16;
    const int nrows = (l == 0) ? R : RL;
    const float* wg = c.p->in[I_MWG] + (size_t)l * D * 4; const float* we = c.p->in[I_MWE] + (size_t)l * D * 32;
    int* lcnt = (int*)((unsigned char*)c.smem + LDS_SH);
    const int tid = c.tid, lane = c.lane, wave = c.wave;
    __syncthreads();
    if (tid < 64) lcnt[tid] = 0;
    pg::bf16x8 breg[3][4];
#pragma unroll
    for (int ct = 0; ct < 3; ++ct)
#pragma unroll
        for (int ks = 0; ks < 4; ++ks) {
            const int col = ct * 16 + (lane & 15), k0 = wave * 128 + ks * 32 + (lane >> 4) * 8;
            unsigned w[4];
#pragma unroll
            for (int j = 0; j < 4; ++j) {
                float a = 0.f, b = 0.f;
                if (col < 4) { a = wg[(k0 + 2 * j) * 4 + col]; b = wg[(k0 + 2 * j + 1) * 4 + col]; }
                else if (col < 36) { a = we[(k0 + 2 * j) * 32 + col - 4]; b = we[(k0 + 2 * j + 1) * 32 + col - 4]; }
                w[j] = (unsigned)f2bf(a) | ((unsigned)f2bf(b) << 16);
            }
            breg[ct][ks] = __builtin_bit_cast(pg::bf16x8, (pg::u32x4){w[0], w[1], w[2], w[3]});
        }
    const int rpb = (nrows + c.nblk - 1) / c.nblk, row0 = c.bid * rpb;
    const int cnt = nrows - row0 < rpb ? (nrows - row0 > 0 ? nrows - row0 : 0) : rpb;
    __syncthreads();
#pragma unroll 1
    for (int sb = 0; sb * 16 < cnt; ++sb) {
        const int nsb = cnt - sb * 16 < 16 ? cnt - sb * 16 : 16;
#pragma unroll 1
        for (int q = 0; q < 2; ++q) {
            const int rl = wave * 2 + q;
            if (rl < nsb) {
                const int r = row0 + sb * 16 + rl;
                float y[16];
                norm_row(c, l, r, 1, y);
#pragma unroll
                for (int j = 0; j < 4; ++j) {
                    const int d = (j * 64 + lane) * 4;
                    const unsigned h0 = pg::cvt_pk_bf16(y[j * 4], y[j * 4 + 1]), h1 = pg::cvt_pk_bf16(y[j * 4 + 2], y[j * 4 + 3]);
                    *(uint2*)(cH(c) + (size_t)r * D + d) = make_uint2(h0, h1);
                    const unsigned l0 = pg::cvt_pk_bf16(y[j * 4] - __uint_as_float(h0 << 16), y[j * 4 + 1] - __uint_as_float(h0 & 0xffff0000u));
                    const unsigned l1 = pg::cvt_pk_bf16(y[j * 4 + 2] - __uint_as_float(h1 << 16), y[j * 4 + 3] - __uint_as_float(h1 & 0xffff0000u));
                    *(PG_LAS pg::u32x2*)(lds + rl * HP + d * 2) = (pg::u32x2){h0, h1};
                    *(PG_LAS pg::u32x2*)(lds + O_LO + rl * HP + d * 2) = (pg::u32x2){l0, l1};
                }
            }
        }
        __syncthreads();
        {
            pg::f32x4 acc[3];
#pragma unroll
            for (int ct = 0; ct < 3; ++ct) acc[ct] = (pg::f32x4){0.f, 0.f, 0.f, 0.f};
#pragma unroll
            for (int ks = 0; ks < 4; ++ks) {
                const int off = (lane & 15) * HP + (wave * 128 + ks * 32 + (lane >> 4) * 8) * 2;
                const pg::bf16x8 ah = *(const PG_LAS pg::bf16x8*)(lds + off), al = *(const PG_LAS pg::bf16x8*)(lds + O_LO + off);
#pragma unroll
                for (int ct = 0; ct < 3; ++ct) {
                    acc[ct] = __builtin_amdgcn_mfma_f32_16x16x32_bf16(ah, breg[ct][ks], acc[ct], 0, 0, 0);
                    acc[ct] = __builtin_amdgcn_mfma_f32_16x16x32_bf16(al, breg[ct][ks], acc[ct], 0, 0, 0);
                }
            }
#pragma unroll
            for (int ct = 0; ct < 3; ++ct) *(PG_LAS pg::f32x4*)(lds + O_PART + ((wave * 3 + ct) * 64 + lane) * 16) = acc[ct];
        }
        __syncthreads();
        if (tid < 256) {
            const int row = tid >> 4, c3 = tid & 15, sl = (row >> 2) * 16 + c3, rg = row & 3;
#pragma unroll
            for (int ct = 0; ct < 3; ++ct) {
                float s = 0.f;
#pragma unroll
                for (int w = 0; w < 8; ++w) s += *(const PG_LAS float*)(lds + O_PART + ((w * 3 + ct) * 64 + sl) * 16 + rg * 4);
                *(PG_LAS float*)(lds + O_LG + (row * 48 + ct * 16 + c3) * 4) = s;
            }
        }
        __syncthreads();
        if (tid < nsb) {
            const int r = row0 + sb * 16 + tid;
            const PG_LAS float* lg = (const PG_LAS float*)(lds + O_LG + tid * 48 * 4);
            float gl[4]; int gi = 0;
#pragma unroll
            for (int i = 0; i < 4; ++i) gl[i] = lg[i] + c.p->in[I_MBG][l * 4 + i];
            float gm = gl[0];
#pragma unroll
            for (int i = 1; i < 4; ++i) if (gl[i] > gm) { gm = gl[i]; gi = i; }
            float se = 0.f;
#pragma unroll
            for (int i = 0; i < 4; ++i) se += expf(gl[i] - gm);
            const float ptop = 1.0f / se;
            float el[8];
#pragma unroll
            for (int i = 0; i < 8; ++i) el[i] = lg[4 + gi * 8 + i] + c.p->in[I_MBE][l * 32 + gi * 8 + i];
            int e1 = 0; float m1 = el[0];
#pragma unroll
            for (int i = 1; i < 8; ++i) if (el[i] > m1) { m1 = el[i]; e1 = i; }
            int e2 = -1; float m2 = -3.0e38f;
#pragma unroll
            for (int i = 0; i < 8; ++i) if (i != e1 && el[i] > m2) { m2 = el[i]; e2 = i; }
            const float ex = expf(m2 - m1);
            const float w1 = ptop / (1.f + ex), w2 = ptop * ex / (1.f + ex);
            const int ea = gi * 8 + e1, eb = gi * 8 + e2;
            const int pa = atomicAdd(&lcnt[ea], 1), pb = atomicAdd(&lcnt[eb], 1);
            cSLOTPOS(c)[r * 2 + 0] = pa; cSLOTPOS(c)[r * 2 + 1] = pb;
            cROUTE_E(c)[r * 2 + 0] = ea; cROUTE_E(c)[r * 2 + 1] = eb;
            cROUTE_W(c)[r * 2 + 0] = w1; cROUTE_W(c)[r * 2 + 1] = w2;
        }
    }
    __syncthreads();
    if (tid < 32) lcnt[32 + tid] = atomicAdd(&cCNT(c)[(l * 32 + tid) * 64], lcnt[tid]);
    __syncthreads();
    for (int i = tid; i < cnt * 2; i += NT) {
        const int idx = row0 * 2 + i;
        const int e = cROUTE_E(c)[idx], pos = lcnt[32 + e] + cSLOTPOS(c)[idx];
        cSLOTPOS(c)[idx] = pos; cSLOTTOK(c)[(size_t)e * SLOTCAP + pos] = idx;
    }
}

struct InprojSched {
    const char* A; const char* Bt; int G, c, l, ldb, sw;
    __device__ __forceinline__ int tile(int q) const { return sw ? (q < 4 ? 2 + q : 6 + q) : (q < 2 ? q : (q < 6 ? 4 + q : 10 + q)); }
    __device__ __forceinline__ bool next(int i, pg::Unit& u) const {
        const int Lx = i * G + c, nN = sw ? 10 : 18;
        if (Lx < 64 * nN) { int q; pg::static_tile(Lx, 64, nN, u.pm, q); u.pn = tile(q); }
        else {
            const int j = Lx - 64 * nN;
            if (l == 0) { if (j >= 4 * nN) return false; u.pm = 64 + j / nN; u.pn = tile(j % nN); }
            else if (sw) { if (j >= 4 * 4) return false; u.pm = 64 + (j >> 2); u.pn = 2 + (j & 3); }
            else { if (j >= 4 * 2) return false; u.pm = 64 + (j >> 1); u.pn = 8 + (j & 1); }
        }
        u.a = A + (size_t)u.pm * 256 * D * 2; u.b = Bt + (size_t)u.pn * 256 * D * 2; u.aux = 0; u.swap = sw;
        return true;
    }
    __device__ __forceinline__ unsigned a_off(const pg::Unit&, int h, int R, int C) const { return (unsigned)(((h * 128 + R) * D + C) * 2); }
};
struct InprojEpiN {
    static constexpr bool MID = false;
    bf16_t *QP, *KR, *AO, *KT2, *BO, *ZG, *AY, *ZHYT, *ZHYTC, *ZGATE; const float* dec;
    __device__ __forceinline__ void operator()(const pg::f32x4 (&acc)[2][2][4][2], const pg::Unit& u, int wr, int wc, int fr, int fq) const {
        const int pn = u.pn, pm = u.pm;
        const int b = pm < 64 ? (pm >> 4) : (pm - 64), chunk = pm < 64 ? 1 + (pm & 15) : 0;
        if (pn < 2) {
#pragma unroll
            for (int bj = 0; bj < 2; ++bj) {
                const int h = 2 * pn + bj, bch = (b * 4 + h) * 17 + chunk, dk0 = wc * 32 + 8 * fq;
                const float lgf = dec[h], lgb = dec[4 + h];
#pragma unroll
                for (int ai = 0; ai < 2; ++ai)
#pragma unroll
                    for (int m = 0; m < 4; ++m) {
                        const int i = ai * 128 + wr * 64 + m * 16 + fr;
                        const float sf = __expf(lgf * (float)(i + 1)), sb = __expf(lgb * (float)(256 - i));
                        pg::f32x4 v0 = acc[ai][bj][m][0] * 0.08838834764831845f, v1 = acc[ai][bj][m][1] * 0.08838834764831845f;
                        *(pg::u32x4*)(QP + ((size_t)bch * 256 + i) * 128 + dk0) = pack8(v0, v1);
                        bf16_t* ao = AO + ((size_t)bch * 256 + i) * 512 + dk0;
                        *(pg::u32x4*)(ao + 256) = pack8(v0 * sf, v1 * sf);
                        *(pg::u32x4*)(ao + 384) = pack8(v0 * sb, v1 * sb);
                        __builtin_amdgcn_sched_barrier(0);
                    }
            }
        } else {
            const int row0 = pm * 256 + wr * 64 + fr, cc0 = wc * 32 + 8 * fq;
#pragma unroll
            for (int ai = 0; ai < 2; ++ai)
#pragma unroll
                for (int m = 0; m < 4; ++m) {
                    const int r = row0 + ai * 128 + m * 16;
#pragma unroll
                    for (int bj = 0; bj < 2; ++bj) {
                        const int cc = cc0 + bj * 128;
                        pg::f32x4 v0 = acc[ai][bj][m][0], v1 = acc[ai][bj][m][1];
                        if (pn < 8) { *(pg::u32x4*)(ZG + (size_t)r * 512 + (pn - 6) * 256 + cc) = pack8(v0, v1); }
                        else if (pn < 10) {
                            const int pos = r < RL ? 256 + (r & 4095) : ((r - RL) & 255);
                            const int ch = (pn - 8) * 256 + cc, g = ch >> 4, p0 = ch & 15;
                            *(pg::u32x4*)(AY + ((size_t)(g * 1280 + b * 272 + (pos >> 4)) * 512 + (pos & 15) * 16 + p0)) = pack8(v0, v1);
                        } else {
#pragma unroll
                            for (int e = 0; e < 4; ++e) { v0[e] = sigmoidf_(v0[e]); v1[e] = sigmoidf_(v1[e]); }
                            *(pg::u32x4*)(ZGATE + (size_t)r * 3072 + (pn - 16) * 256 + cc) = pack8(v0, v1);
                        }
                        __builtin_amdgcn_sched_barrier(0);
                    }
                }
        }
    }
};
struct InprojEpiT {
    static constexpr bool MID = false;
    bf16_t *QP, *KR, *AO, *KT2, *BO, *ZG, *AY, *ZHYT, *ZHYTC, *ZGATE; const float* dec;
    __device__ __forceinline__ void operator()(const pg::f32x4 (&acc)[2][2][4][2], const pg::Unit& u, int wr, int wc, int fr, int fq) const {
        const int pn = u.pn, pm = u.pm;
        const int b = pm < 64 ? (pm >> 4) : (pm - 64), chunk = pm < 64 ? 1 + (pm & 15) : 0;
        if (pn < 4) {
#pragma unroll
            for (int bj = 0; bj < 2; ++bj) {
                const int h = 2 * (pn - 2) + bj, bch = (b * 4 + h) * 17 + chunk;
                const float lgf = dec[h], lgb = dec[4 + h];
#pragma unroll
                for (int ai = 0; ai < 2; ++ai)
#pragma unroll
                    for (int m = 0; m < 4; ++m) {
                        const int j0 = ai * 128 + wr * 64 + m * 16 + 4 * fq;
                        float wf[4], wb[4];
#pragma unroll
                        for (int e = 0; e < 4; ++e) { wf[e] = __expf(lgf * (float)(255 - j0 - e)); wb[e] = __expf(lgb * (float)(j0 + e)); }
#pragma unroll
                        for (int n = 0; n < 2; ++n) {
                            const int dk = wc * 32 + 8 * (fr >> 2) + 4 * n + (fr & 3);
                            const pg::f32x4 v = acc[ai][bj][m][n];
#pragma unroll
                            for (int e = 0; e < 4; ++e) KR[((size_t)bch * 256 + j0 + e) * 128 + dk] = f2bf(v[e]);
                            pg::u32x2 w; w.x = pg::cvt_pk_bf16(v[0] * wf[0], v[1] * wf[1]); w.y = pg::cvt_pk_bf16(v[2] * wf[2], v[3] * wf[3]);
                            *(pg::u32x2*)(KT2 + ((size_t)bch * 256 + dk) * 256 + j0) = w;
                            w.x = pg::cvt_pk_bf16(v[0] * wb[0], v[1] * wb[1]); w.y = pg::cvt_pk_bf16(v[2] * wb[2], v[3] * wb[3]);
                            *(pg::u32x2*)(KT2 + ((size_t)bch * 256 + 128 + dk) * 256 + j0) = w;
                            __builtin_amdgcn_sched_barrier(0);
                        }
                    }
            }
        } else if (pn < 6) {
#pragma unroll
            for (int bj = 0; bj < 2; ++bj) {
                const int h = 2 * (pn - 4) + bj, bch = (b * 4 + h) * 17 + chunk;
#pragma unroll
                for (int ai = 0; ai < 2; ++ai)
#pragma unroll
                    for (int m = 0; m < 4; ++m) {
                        const int j0 = ai * 128 + wr * 64 + m * 16 + 4 * fq;
#pragma unroll
                        for (int n = 0; n < 2; ++n) {
                            const int dv = wc * 32 + 8 * (fr >> 2) + 4 * n + (fr & 3);
                            const pg::f32x4 v = acc[ai][bj][m][n];
                            pg::u32x2 w; w.x = pg::cvt_pk_bf16(v[0], v[1]); w.y = pg::cvt_pk_bf16(v[2], v[3]);
                            *(pg::u32x2*)(BO + ((size_t)bch * 128 + dv) * 512 + j0) = w;
                            __builtin_amdgcn_sched_barrier(0);
                        }
                    }
            }
        } else {
#pragma unroll
            for (int bj = 0; bj < 2; ++bj)
#pragma unroll
                for (int ai = 0; ai < 2; ++ai)
#pragma unroll
                    for (int m = 0; m < 4; ++m) {
                        const int i0 = ai * 128 + wr * 64 + m * 16 + 4 * fq;
#pragma unroll
                        for (int n = 0; n < 2; ++n) {
                            const int hc = (pn - 10) * 256 + bj * 128 + wc * 32 + 8 * (fr >> 2) + 4 * n + (fr & 3);
                            const pg::f32x4 v = acc[ai][bj][m][n];
                            pg::u32x2 w; w.x = pg::cvt_pk_bf16(v[0], v[1]); w.y = pg::cvt_pk_bf16(v[2], v[3]);
                            if (pm < 64) *(pg::u32x2*)(ZHYT + ((size_t)(hc * 4 + b) * 4096) + (pm & 15) * 256 + i0) = w;
                            else *(pg::u32x2*)(ZHYTC + ((size_t)(hc * 4 + b) * 256) + i0) = w;
                            __builtin_amdgcn_sched_barrier(0);
                        }
                    }
        }
    }
};
__device__ __forceinline__ void phase_inproj(const Ctx& c, int l) {
    { InprojSched S{(const char*)cH(c), (const char*)cWINT(c), c.nblk, c.bid, l, 1024, 0};
      InprojEpiN E{cQP(c), cKR(c), cAO(c), cKT2(c), cBO(c), cZG(c), cAY(c), cZHYT(c), cZHYTC(c), cZGATE(c), c.p->in[I_RETDEC] + l * 8};
      pg::gemm_phase<false>((PG_LAS unsigned char*)c.smem, D, S, E, opq(c.tid)); }
    { InprojSched S{(const char*)cH(c), (const char*)cWINT(c), c.nblk, c.bid, l, 1024, 1};
      InprojEpiT E{cQP(c), cKR(c), cAO(c), cKT2(c), cBO(c), cZG(c), cAY(c), cZHYT(c), cZHYTC(c), cZGATE(c), c.p->in[I_RETDEC] + l * 8};
      pg::gemm_phase<true>((PG_LAS unsigned char*)c.smem, D, S, E, opq(c.tid)); }
}

struct RetSched {
    const char* A; const char* Bt; int G, c, mode, l, ldb;
    __device__ __forceinline__ bool next(int i, pg::Unit& u) const {
        const int Lx = i * G + c;
        int bch;
        if (mode == 2 || l == 0) { if (Lx >= 272) return false; bch = Lx; }
        else { if (Lx >= 256) return false; bch = (Lx >> 4) * 17 + 1 + (Lx & 15); }
        u.pm = bch; u.pn = 0; u.aux = bch; u.swap = (mode == 2) ? 1 : 0;
        if (mode == 1) { u.a = A + (size_t)bch * 256 * 128 * 2; u.b = Bt + (size_t)bch * 256 * 128 * 2; }
        else if (mode == 2) { u.a = A + (size_t)bch * 256 * 256 * 2; u.b = Bt + (size_t)bch * 128 * 512 * 2; }
        else { u.a = A + (size_t)bch * 256 * 512 * 2; u.b = Bt + (size_t)bch * 128 * 512 * 2; }
        return true;
    }
    __device__ __forceinline__ unsigned a_off(const pg::Unit&, int h, int R, int C) const {
        const int lda = mode == 1 ? 128 : (mode == 2 ? 256 : 512);
        return (unsigned)(((h * 128 + R) * lda + C) * 2);
    }
};
struct RetU1Epi {
    static constexpr bool MID = false;
    bf16_t* AO; const float* dec;
    __device__ __forceinline__ void operator()(const pg::f32x4 (&acc)[2][2][4][2], const pg::Unit& u, int wr, int wc, int fr, int fq) const {
        const int bch = u.aux, h = (bch / 17) & 3;
        const float lgf = dec[h], lgb = dec[4 + h];
#pragma unroll
        for (int ai = 0; ai < 2; ++ai)
#pragma unroll
            for (int m = 0; m < 4; ++m) {
                const int i = ai * 128 + wr * 64 + m * 16 + fr;
#pragma unroll
                for (int bj = 0; bj < 2; ++bj) {
                    const int j0 = bj * 128 + wc * 32 + 8 * fq;
                    pg::f32x4 v0 = acc[ai][bj][m][0], v1 = acc[ai][bj][m][1];
#pragma unroll
                    for (int e = 0; e < 4; ++e) {
                        const int ja = j0 + e, jb = j0 + 4 + e;
                        v0[e] *= __expf((ja <= i) ? lgf * (float)(i - ja) : lgb * (float)(ja - i));
                        v1[e] *= __expf((jb <= i) ? lgf * (float)(i - jb) : lgb * (float)(jb - i));
                    }
                    *(pg::u32x4*)(AO + ((size_t)bch * 256 + i) * 512 + j0) = pack8(v0, v1);
                    __builtin_amdgcn_sched_barrier(0);
                }
            }
    }
};
struct RetU2Epi {
    static constexpr bool MID = false;
    float* DST;
    __device__ __forceinline__ void operator()(const pg::f32x4 (&acc)[2][2][4][2], const pg::Unit& u, int wr, int wc, int fr, int fq) const {
        const int bch = u.aux;
#pragma unroll
        for (int m = 0; m < 4; ++m) {
            const int dv = wr * 64 + m * 16 + fr;
            float* dst = DST + ((size_t)bch * 128 + dv) * 256 + wc * 32 + 8 * fq;
#pragma unroll
            for (int bj = 0; bj < 2; ++bj) { *(pg::f32x4*)(dst + bj * 128) = acc[0][bj][m][0]; *(pg::f32x4*)(dst + bj * 128 + 4) = acc[0][bj][m][1]; }
        }
    }
};
struct RetU3Epi {
    static constexpr bool MID = false;
    bf16_t* YCAT; const bf16_t* ZG; const float* gn; PG_LAS float* part;
    __device__ __forceinline__ void operator()(const pg::f32x4 (&acc)[2][2][4][2], const pg::Unit& u, int wr, int wc, int fr, int fq) const {
        const int bch = u.aux, chunk = bch % 17, bh = bch / 17, b = bh >> 2, h = bh & 3;
        const int rbase = chunk == 0 ? RL + b * 256 : b * L + (chunk - 1) * 256;
        const int lane = fq * 16 + fr, col = h * 128 + wc * 32 + 8 * fq;
#pragma unroll
        for (int ai = 0; ai < 2; ++ai)
#pragma unroll
            for (int m = 0; m < 4; ++m) {
                const pg::f32x4 a0 = acc[ai][0][m][0], a1 = acc[ai][0][m][1];
                float s = (a0[0] + a0[1]) + (a0[2] + a0[3]) + (a1[0] + a1[1]) + (a1[2] + a1[3]);
                float q = (a0[0] * a0[0] + a0[1] * a0[1]) + (a0[2] * a0[2] + a0[3] * a0[3]) + (a1[0] * a1[0] + a1[1] * a1[1]) + (a1[2] * a1[2] + a1[3] * a1[3]);
                s += shx(s, 16, lane); q += shx(q, 16, lane); s += shx(s, 32, lane); q += shx(q, 32, lane);
                if (fq == 0) { const int i = ai * 128 + wr * 64 + m * 16 + fr; typedef float f32x2v __attribute__((ext_vector_type(2))); *(PG_LAS f32x2v*)(part + (i * 4 + wc) * 2) = (f32x2v){s, q}; }
            }
        asm volatile("s_waitcnt lgkmcnt(0)" ::: "memory"); __builtin_amdgcn_s_barrier(); asm volatile("" ::: "memory");
        float gv[8];
        { const float4 g0 = *(const float4*)(gn + col), g1 = *(const float4*)(gn + col + 4); gv[0] = g0.x; gv[1] = g0.y; gv[2] = g0.z; gv[3] = g0.w; gv[4] = g1.x; gv[5] = g1.y; gv[6] = g1.z; gv[7] = g1.w; }
#pragma unroll
        for (int ai = 0; ai < 2; ++ai)
#pragma unroll
            for (int m = 0; m < 4; ++m) {
                const int i = ai * 128 + wr * 64 + m * 16 + fr;
                const pg::f32x4 p0 = *(const PG_LAS pg::f32x4*)(part + i * 8), p1 = *(const PG_LAS pg::f32x4*)(part + i * 8 + 4);
                const float mu = ((p0[0] + p0[2]) + (p1[0] + p1[2])) * (1.f / 128.f);
                const float var = fmaxf(((p0[1] + p0[3]) + (p1[1] + p1[3])) * (1.f / 128.f) - mu * mu, 0.f);
                const float rinv = rsqrtf(var + 1e-5f);
                float g[8]; unpack8(*(const pg::u32x4*)(ZG + (size_t)(rbase + i) * 512 + col), g);
                const pg::f32x4 a0 = acc[ai][0][m][0], a1 = acc[ai][0][m][1];
                pg::f32x4 v0, v1;
#pragma unroll
                for (int e = 0; e < 4; ++e) { v0[e] = (a0[e] - mu) * rinv * gv[e] * siluf_(g[e]); v1[e] = (a1[e] - mu) * rinv * gv[4 + e] * siluf_(g[4 + e]); }
                *(pg::u32x4*)(YCAT + (size_t)(rbase + i) * 1536 + col) = pack8(v0, v1);
            }
    }
};
__device__ __forceinline__ void ret_carry(const Ctx& c, int l) {
    const int gtid = c.bid * NT + c.tid, gthreads = c.nblk * NT;
    for (int idx = gtid; idx < 16 * 128 * 256; idx += gthreads) {
        const int bh = idx >> 15, dv = (idx >> 8) & 127, col = idx & 255, dir = col >> 7, h = bh & 3;
        const float g256 = __expf(256.f * c.p->in[I_RETDEC][(l * 2 + dir) * 4 + h]);
        float dd[17];
#pragma unroll
        for (int q = 0; q < 17; ++q) {
            const int chunk = dir == 0 ? q : (q == 0 ? 0 : 17 - q);
            dd[q] = cDST(c)[((size_t)(bh * 17 + chunk) * 128 + dv) * 256 + col];
        }
        float s = 0.f;
#pragma unroll
        for (int q = 0; q < 17; ++q) {
            const int chunk = dir == 0 ? q : (q == 0 ? 0 : 17 - q);
            cBO(c)[((size_t)(bh * 17 + chunk) * 128 + dv) * 512 + 256 + col] = f2bf(s);
            s = g256 * s + dd[q];
        }
    }
}
__device__ __forceinline__ void ret_finalize(const Ctx& c, int l) {
    const int gw = c.bid * 8 + c.wave, nw = c.nblk * 8;
    const int nrows = (l == 0) ? R : RL;
    for (int r = gw; r < nrows; r += nw) {
        float o[8], g[8];
        unpack8(*(const pg::u32x4*)(cOR(c) + (size_t)r * 512 + c.lane * 8), o);
        unpack8(*(const pg::u32x4*)(cZG(c) + (size_t)r * 512 + c.lane * 8), g);
        float s = 0.f;
#pragma unroll
        for (int i = 0; i < 8; ++i) s += o[i];
#pragma unroll
        for (int ofs = 8; ofs >= 1; ofs >>= 1) s += shx(s, ofs, c.lane);
        const float mu = s * (1.f / 128.f);
        float vs = 0.f;
#pragma unroll
        for (int i = 0; i < 8; ++i) { const float dlt = o[i] - mu; vs += dlt * dlt; }
#pragma unroll
        for (int ofs = 8; ofs >= 1; ofs >>= 1) vs += shx(vs, ofs, c.lane);
        const float rinv = rsqrtf(vs * (1.f / 128.f) + 1e-5f);
        const float* gn = c.p->in[I_RETGN] + l * 512 + c.lane * 8;
        pg::f32x4 v0, v1;
#pragma unroll
        for (int i = 0; i < 4; ++i) { v0[i] = (o[i] - mu) * rinv * gn[i] * siluf_(g[i]); v1[i] = (o[4 + i] - mu) * rinv * gn[4 + i] * siluf_(g[4 + i]); }
        *(pg::u32x4*)(cYCAT(c) + (size_t)r * 1536 + c.lane * 8) = pack8(v0, v1);
    }
}

constexpr int HY_LENC = 4240, HY_UB = 8 * HY_LENC * 2, HY_LU = 4616, HY_X0 = HY_UB + 4 * HY_LU * 2;
typedef float f32x16 __attribute__((ext_vector_type(16)));
__device__ __forceinline__ void hy_conv3v(const pg::u32x4& w, float xm, float xp, float w0, float w1, float w2, float bs, float (&o)[8]) {
    float x[10];
    unpack8(w, *(float (*)[8])&x[1]); x[0] = xm; x[9] = xp;
#pragma unroll
    for (int j = 0; j < 8; ++j) o[j] = bs + w0 * x[j] + w1 * x[j + 1] + w2 * x[j + 2];
}
__device__ __forceinline__ void hy_channel(const Ctx& c, int l, int ch, const bool isctx) {
    PG_LAS unsigned char* lds = (PG_LAS unsigned char*)c.smem;
    const int tid = c.tid, lane = c.lane, wave = c.wave;
    const int Lq = isctx ? LC : L, half = Lq / 2;
    const bf16_t* hsrc = isctx ? cFILTC(c) + (size_t)ch * LC : cFILT(c) + ((size_t)l * 512 + ch) * L;
    const bf16_t* zbase = isctx ? cZHYTC(c) : cZHYT(c);
    __syncthreads();
    PG_LAS bf16_t* hst = (PG_LAS bf16_t*)(lds + HY_X0 + 4 * 4096 * 2);
    if (tid * 8 < Lq) *(PG_LAS pg::u32x4*)(hst + tid * 8) = *(const pg::u32x4*)(hsrc + tid * 8);
    __syncthreads();
    const int nch = isctx ? 48 : 530;
    for (int i = tid; i < nch; i += NT) {
        const int c0i = Lq / 8 + 7 - i, c1i = c0i - 1;
        pg::u32x4 h0v = (pg::u32x4){0u, 0u, 0u, 0u}, h1v = h0v;
        if (c0i >= 0 && c0i < Lq / 8) h0v = *(const PG_LAS pg::u32x4*)(hst + c0i * 8);
        if (c1i >= 0 && c1i < Lq / 8) h1v = *(const PG_LAS pg::u32x4*)(hst + c1i * 8);
        unsigned cat[9];
#pragma unroll
        for (int j = 0; j < 4; ++j) { const unsigned a = h0v[3 - j], b = h1v[3 - j]; cat[j] = (a >> 16) | (a << 16); cat[4 + j] = (b >> 16) | (b << 16); }
        cat[8] = 0u;
#pragma unroll
        for (int s = 0; s < 8; ++s) {
            pg::u32x4 o;
#pragma unroll
            for (int j = 0; j < 4; ++j) o[j] = (s & 1) ? ((cat[j + (s >> 1)] >> 16) | (cat[j + (s >> 1) + 1] << 16)) : cat[j + (s >> 1)];
            *(PG_LAS pg::u32x4*)(lds + s * (HY_LENC * 2) + i * 16) = o;
        }
    }
    {
        const float* sw = c.p->in[I_HYSW] + (size_t)l * 3 * 1536; const float* sb = c.p->in[I_HYSB] + l * 1536;
        const float a0 = sw[ch], a1 = sw[1536 + ch], a2 = sw[3072 + ch], ab = sb[ch];
        const float b0 = sw[512 + ch], b1 = sw[1536 + 512 + ch], b2 = sw[3072 + 512 + ch], bb = sb[512 + ch];
        const float c0 = sw[1024 + ch], c1 = sw[1536 + 1024 + ch], c2 = sw[3072 + 1024 + ch], cb = sb[1024 + ch];
        const int cpb = Lq / 8, nit = isctx ? 1 : 4;
        pg::u32x4 wv[4][3];
        float em[4][3], ep[4][3];
#pragma unroll
        for (int it = 0; it < 4; ++it) {
            if (it < nit) {
                const int idx = tid + it * NT, b = idx / cpb, t8 = (idx % cpb) * 8;
                const bool act = idx < 4 * cpb;
#pragma unroll
                for (int q = 0; q < 3; ++q) {
                    const bf16_t* z = zbase + (size_t)((q * 512 + ch) * 4 + (act ? b : 0)) * Lq;
                    wv[it][q] = act ? *(const pg::u32x4*)(z + t8) : (pg::u32x4){0u, 0u, 0u, 0u};
                    em[it][q] = (act && lane == 0 && t8 > 0) ? bf2f(z[t8 - 1]) : 0.f;
                    ep[it][q] = (act && lane == 63 && t8 + 8 < Lq) ? bf2f(z[t8 + 8]) : 0.f;
                }
            }
        }
#pragma unroll
        for (int it = 0; it < 4; ++it) {
            if (it < nit) {
                const int idx = tid + it * NT, b = idx / cpb, t8 = (idx % cpb) * 8;
                float xq[3][8];
#pragma unroll
                for (int q = 0; q < 3; ++q) {
                    const unsigned up = (unsigned)__builtin_amdgcn_ds_bpermute(((lane + 63) & 63) << 2, (int)wv[it][q][3]);
                    const unsigned dn = (unsigned)__builtin_amdgcn_ds_bpermute(((lane + 1) & 63) << 2, (int)wv[it][q][0]);
                    const float xm = lane == 0 ? em[it][q] : (t8 > 0 ? __uint_as_float(up & 0xffff0000u) : 0.f);
                    const float xp = lane == 63 ? ep[it][q] : (t8 + 8 < Lq ? __uint_as_float(dn << 16) : 0.f);
                    hy_conv3v(wv[it][q], xm, xp, q == 0 ? a0 : (q == 1 ? b0 : c0), q == 0 ? a1 : (q == 1 ? b1 : c1), q == 0 ? a2 : (q == 1 ? b2 : c2), q == 0 ? ab : (q == 1 ? bb : cb), xq[q]);
                }
                if (idx < 4 * cpb) {
                    pg::f32x4 u0, u1, y0, y1;
#pragma unroll
                    for (int j = 0; j < 4; ++j) { u0[j] = xq[1][j] * xq[2][j]; u1[j] = xq[1][4 + j] * xq[2][4 + j]; y0[j] = xq[0][j]; y1[j] = xq[0][4 + j]; }
                    *(PG_LAS pg::u32x4*)(lds + HY_UB + (b * HY_LU + 256 + t8) * 2) = pack8(u0, u1);
                    *(PG_LAS pg::u32x4*)(lds + HY_X0 + (b * 4096 + t8) * 2) = pack8(y0, y1);
                }
            }
        }
        if (isctx) for (int idx = tid; idx < 4 * 32; idx += NT) *(PG_LAS pg::u32x4*)(lds + HY_UB + ((idx >> 5) * HY_LU + 512 + (idx & 31) * 8) * 2) = (pg::u32x4){0u, 0u, 0u, 0u};
    }
    __syncthreads();
    const int r = lane & 31, hh = lane >> 5, i_n = r >> 2, bq = r & 3;
    const float bias = c.p->in[I_HYBIAS][l * 512 + ch];
    bf16_t* ydst = isctx ? cYHYTC(c) + (size_t)(ch * 4 + bq) * LC : cYHYT(c) + (size_t)(ch * 4 + bq) * L;
    const int ntile = isctx ? (wave == 0 ? 1 : 0) : 2;
#pragma unroll 1
    for (int ts = 0; ts < ntile; ++ts) {
        const int T0 = (ts ? 15 - wave : wave) * 256;
        int dlo = -(half + 16), dhi = half;
        if (T0 - (Lq - 16) > dlo) dlo = T0 - (Lq - 16);
        if (T0 + 224 < dhi) dhi = T0 + 224;
        const int nst = (dhi - dlo) / 16 + 1;
        const int qq = 64 + Lq - 1 - half - dlo - r + 8 * hh, s = qq & 7;
        const PG_LAS unsigned char* pA = lds + s * (HY_LENC * 2) + (qq - s) * 2;
        const PG_LAS unsigned char* pB = lds + HY_UB + (bq * HY_LU + 256 + T0 + 32 * i_n - dlo + 8 * hh) * 2;
        f32x16 acc;
#pragma unroll
        for (int i = 0; i < 16; ++i) acc[i] = 0.f;
        {
            pg::bf16x8 fa[4], fb[4];
#pragma unroll
            for (int k = 0; k < 4; ++k) { const int sk = k < nst ? k : nst - 1; fa[k] = *(const PG_LAS pg::bf16x8*)(pA - 32 * sk); fb[k] = *(const PG_LAS pg::bf16x8*)(pB - 32 * sk); }
            int st = 0;
#pragma unroll 1
            for (; st + 4 <= nst; st += 4) {
                pg::bf16x8 na[4], nb[4];
#pragma unroll
                for (int k = 0; k < 4; ++k) { const int sk = st + 4 + k < nst ? st + 4 + k : nst - 1; na[k] = *(const PG_LAS pg::bf16x8*)(pA - 32 * sk); nb[k] = *(const PG_LAS pg::bf16x8*)(pB - 32 * sk); }
#pragma unroll
                for (int k = 0; k < 4; ++k) acc = __builtin_amdgcn_mfma_f32_32x32x16_bf16(fa[k], fb[k], acc, 0, 0, 0);
#pragma unroll
                for (int k = 0; k < 4; ++k) { fa[k] = na[k]; fb[k] = nb[k]; }
            }
            if (st < nst) acc = __builtin_amdgcn_mfma_f32_32x32x16_bf16(fa[0], fb[0], acc, 0, 0, 0);
            if (st + 1 < nst) acc = __builtin_amdgcn_mfma_f32_32x32x16_bf16(fa[1], fb[1], acc, 0, 0, 0);
            if (st + 2 < nst) acc = __builtin_amdgcn_mfma_f32_32x32x16_bf16(fa[2], fb[2], acc, 0, 0, 0);
        }
#pragma unroll
        for (int q = 0; q < 4; ++q) {
            const int t = T0 + 32 * i_n + 8 * q + 4 * hh;
            const pg::u32x2 uw = *(const PG_LAS pg::u32x2*)(lds + HY_UB + (bq * HY_LU + 256 + t) * 2);
            const pg::u32x2 xw = *(const PG_LAS pg::u32x2*)(lds + HY_X0 + (bq * 4096 + t) * 2);
            const float u0 = __uint_as_float(uw.x << 16), u1 = __uint_as_float(uw.x & 0xffff0000u), u2 = __uint_as_float(uw.y << 16), u3 = __uint_as_float(uw.y & 0xffff0000u);
            const float x0 = __uint_as_float(xw.x << 16), x1 = __uint_as_float(xw.x & 0xffff0000u), x2 = __uint_as_float(xw.y << 16), x3 = __uint_as_float(xw.y & 0xffff0000u);
            pg::u32x2 o; o.x = pg::cvt_pk_bf16(x0 * (acc[4 * q] + u0 * bias), x1 * (acc[4 * q + 1] + u1 * bias)); o.y = pg::cvt_pk_bf16(x2 * (acc[4 * q + 2] + u2 * bias), x3 * (acc[4 * q + 3] + u3 * bias));
            *(pg::u32x2*)(ydst + t) = o;
        }
    }
}
__device__ __forceinline__ void hy_phase(const Ctx& c, int l) {
    PG_LAS unsigned char* lds = (PG_LAS unsigned char*)c.smem;
    __syncthreads();
    for (int idx = c.tid; idx < 4 * 64; idx += NT) {
        const int b = idx >> 6, k = idx & 63;
        const int e = k < 32 ? k * 8 : 4352 + (k - 32) * 8;
        *(PG_LAS pg::u32x4*)(lds + HY_UB + (b * HY_LU + e) * 2) = (pg::u32x4){0u, 0u, 0u, 0u};
    }
#pragma unroll 1
    for (int ch = c.bid; ch < 512; ch += c.nblk) hy_channel(c, l, ch, false);
    if (l == 0) {
#pragma unroll 1
        for (int ch = c.bid; ch < 512; ch += c.nblk) hy_channel(c, l, ch, true);
    }
}
__device__ __forceinline__ void hy_transpose(const Ctx& c, int l, int rank, int nrank) {
    bf16_t* tile = (bf16_t*)c.smem;
    const int nit = 2048 + (l == 0 ? 128 : 0);
#pragma unroll 1
    for (int it = rank; it < nit; it += nrank) {
        int b, t0, c0, Lq; const bf16_t* srcb; size_t rowbase;
        if (it < 2048) { b = it >> 9; t0 = ((it >> 3) & 63) * 64; c0 = (it & 7) * 64; Lq = L; srcb = cYHYT(c); rowbase = (size_t)b * L; }
        else { const int k = it - 2048; b = k >> 5; t0 = ((k >> 3) & 3) * 64; c0 = (k & 7) * 64; Lq = LC; srcb = cYHYTC(c); rowbase = (size_t)RL + b * LC; }
        __syncthreads();
        { const int cc = c.tid >> 3, t8 = (c.tid & 7) * 8;
          *(uint4*)(tile + cc * 72 + t8) = *(const uint4*)(srcb + (size_t)((c0 + cc) * 4 + b) * Lq + t0 + t8); }
        __syncthreads();
        { const int tp = c.tid & 31, cg = c.tid >> 5;
          unsigned w[4];
#pragma unroll
          for (int j = 0; j < 4; ++j) w[j] = *(const unsigned*)(tile + (cg * 4 + j) * 72 + tp * 2);
          bf16_t* dst = cYCAT(c) + (rowbase + t0 + tp * 2) * 1536 + 1024 + c0 + cg * 4;
          *(uint2*)dst = make_uint2((w[0] & 0xffffu) | (w[1] << 16), (w[2] & 0xffffu) | (w[3] << 16));
          *(uint2*)(dst + 1536) = make_uint2((w[0] >> 16) | (w[1] & 0xffff0000u), (w[2] >> 16) | (w[3] & 0xffff0000u)); }
    }
}

__device__ __forceinline__ void s5_param_item(const Ctx& c, int l, int g) {
    float* ap = c.smem;
    float* Bb = ap + 2 * 17 * 130;
    float* Cc = Bb + 2 * 64 * 16 * 2;
    float* Kt = Cc + 2 * 16 * 130;
    const int tid = c.tid;
    __syncthreads();
    if (tid < 128) {
        const int d = tid >> 6, n = tid & 63, pg_ = (l * 2 + d) * 32 + g;
        const float lr = c.p->in[I_LRE][pg_ * 64 + n], li = c.p->in[I_LIM][pg_ * 64 + n], dt = expf(c.p->in[I_LOGDT][pg_]);
        for (int j = 0; j <= 16; ++j) { const float er = __expf((float)j * lr * dt), ang = (float)j * li * dt; ap[(d * 17 + j) * 130 + n * 2] = er * __cosf(ang); ap[(d * 17 + j) * 130 + n * 2 + 1] = er * __sinf(ang); }
        const float ar = expf(lr * dt) * cosf(li * dt), ai = expf(lr * dt) * sinf(li * dt);
        const float nr = ar - 1.f, ni = ai, den = lr * lr + li * li;
        const float cr = (nr * lr + ni * li) / den, ci = (ni * lr - nr * li) / den;
        for (int q = 0; q < 16; ++q) {
            const float br = c.p->in[I_BRE][((size_t)pg_ * 64 + n) * 16 + q], bi = c.p->in[I_BIM][((size_t)pg_ * 64 + n) * 16 + q];
            Bb[((d * 64 + n) * 16 + q) * 2] = cr * br - ci * bi; Bb[((d * 64 + n) * 16 + q) * 2 + 1] = cr * bi + ci * br;
        }
    }
    for (int i = tid; i < 2 * 16 * 64; i += NT) {
        const int d = i >> 10, q = (i >> 6) & 15, n = i & 63, pg_ = (l * 2 + d) * 32 + g;
        Cc[(d * 16 + q) * 130 + n * 2] = c.p->in[I_CRE][((size_t)pg_ * 16 + q) * 64 + n]; Cc[(d * 16 + q) * 130 + n * 2 + 1] = c.p->in[I_CIM][((size_t)pg_ * 16 + q) * 64 + n];
    }
    __syncthreads();
    {
        const int d = tid >> 8, j = (tid >> 4) & 15, p = tid & 15;
        float s[16];
#pragma unroll
        for (int q = 0; q < 16; ++q) s[q] = 0.f;
        for (int n = 0; n < 64; ++n) {
            const float xr = Cc[(d * 16 + p) * 130 + n * 2], xi = Cc[(d * 16 + p) * 130 + n * 2 + 1];
            const float pr = ap[(d * 17 + j) * 130 + n * 2], pi = ap[(d * 17 + j) * 130 + n * 2 + 1];
            const float zr = xr * pr - xi * pi, zi = xr * pi + xi * pr;
#pragma unroll
            for (int q = 0; q < 16; ++q) s[q] += zr * Bb[((d * 64 + n) * 16 + q) * 2] - zi * Bb[((d * 64 + n) * 16 + q) * 2 + 1];
        }
#pragma unroll
        for (int q = 0; q < 16; ++q) Kt[((d * 16 + j) * 16 + p) * 16 + q] = s[q];
    }
    __syncthreads();
    bf16_t* PE = cPE(c) + (size_t)(l * 32 + g) * 256 * 256;
#pragma unroll 2
    for (int gi = tid; gi < 256 * 32; gi += NT) {
        const int row = gi >> 5, kg = gi & 31, d = row >> 7, ri = (row >> 6) & 1, n = row & 63, sg = kg >> 1, p0 = (kg & 1) * 8;
        const int e = d == 0 ? 15 - sg : sg;
        const float2 pw = *(const float2*)&ap[(d * 17 + e) * 130 + n * 2];
        const float4* bb = (const float4*)&Bb[((d * 64 + n) * 16 + p0) * 2];
        pg::f32x4 v0, v1;
#pragma unroll
        for (int j = 0; j < 4; ++j) {
            const float4 b2 = bb[j];
            const float o0 = ri ? (pw.x * b2.y + pw.y * b2.x) : (pw.x * b2.x - pw.y * b2.y);
            const float o1 = ri ? (pw.x * b2.w + pw.y * b2.z) : (pw.x * b2.z - pw.y * b2.w);
            if (j < 2) { v0[2 * j] = o0; v0[2 * j + 1] = o1; } else { v1[2 * j - 4] = o0; v1[2 * j - 3] = o1; }
        }
        *(pg::u32x4*)(PE + (size_t)row * 256 + kg * 8) = pack8(v0, v1);
    }
    bf16_t* PY = cPY(c) + (size_t)(l * 32 + g) * 256 * 512;
#pragma unroll 2
    for (int gi = tid; gi < 256 * 64; gi += NT) {
        const int row = gi >> 6, kg = gi & 63, tau = row >> 4, p = row & 15;
        pg::f32x4 v0 = {0.f, 0.f, 0.f, 0.f}, v1 = {0.f, 0.f, 0.f, 0.f};
        if (kg < 32) {
            const int sg = kg >> 1, q0 = (kg & 1) * 8;
            if (sg <= tau) { const float4* kp = (const float4*)&Kt[((0 * 16 + (tau - sg)) * 16 + p) * 16 + q0]; const float4 a = kp[0], b = kp[1]; v0[0] += a.x; v0[1] += a.y; v0[2] += a.z; v0[3] += a.w; v1[0] += b.x; v1[1] += b.y; v1[2] += b.z; v1[3] += b.w; }
            if (sg >= tau) { const float4* kp = (const float4*)&Kt[((1 * 16 + (sg - tau)) * 16 + p) * 16 + q0]; const float4 a = kp[0], b = kp[1]; v0[0] += a.x; v0[1] += a.y; v0[2] += a.z; v0[3] += a.w; v1[0] += b.x; v1[1] += b.y; v1[2] += b.z; v1[3] += b.w; }
        } else {
            const int kk0 = kg * 8 - 256, d = kk0 >> 7, ri = (kk0 >> 6) & 1, n0 = kk0 & 63;
            const int e = d == 0 ? tau + 1 : 16 - tau;
            const float2* xc = (const float2*)&Cc[(d * 16 + p) * 130 + n0 * 2];
            const float2* pa = (const float2*)&ap[(d * 17 + e) * 130 + n0 * 2];
#pragma unroll
            for (int j = 0; j < 8; ++j) {
                const float2 x = xc[j], pw = pa[j];
                const float o = ri ? -(x.x * pw.y + x.y * pw.x) : (x.x * pw.x - x.y * pw.y);
                if (j < 4) v0[j] = o; else v1[j - 4] = o;
            }
        }
        *(pg::u32x4*)(PY + (size_t)row * 512 + kg * 8) = pack8(v0, v1);
    }
}
struct S5Sched {
    const char* AY; const char* P; int G, c, K, ldb;
    __device__ __forceinline__ bool next(int i, pg::Unit& u) const {
        const int Lx = i * G + c; if (Lx >= 160) return false;
        const int g = Lx / 5, rt = Lx % 5;
        u.pm = rt; u.pn = 0; u.aux = g; u.swap = 0;
        u.a = AY + ((size_t)(g * 1280 + rt * 256) * 512) * 2; u.b = P + (size_t)g * 256 * K * 2; return true;
    }
    __device__ __forceinline__ unsigned a_off(const pg::Unit&, int h, int R, int C) const { return (unsigned)(((h * 128 + R) * 512 + C) * 2); }
};
struct S5EEpi {
    static constexpr bool MID = false;
    float* EOUT;
    __device__ __forceinline__ void operator()(const pg::f32x4 (&acc)[2][2][4][2], const pg::Unit& u, int wr, int wc, int fr, int fq) const {
        const int row0 = u.pm * 256 + wr * 64 + fr, col0 = wc * 32 + 8 * fq;
#pragma unroll
        for (int ai = 0; ai < 2; ++ai)
#pragma unroll
            for (int m = 0; m < 4; ++m) {
                const int r = row0 + ai * 128 + m * 16;
                if (r < 1088) {
                    float* dst = EOUT + ((size_t)u.aux * 1088 + r) * 256 + col0;
#pragma unroll
                    for (int bj = 0; bj < 2; ++bj) { *(pg::f32x4*)(dst + bj * 128) = acc[ai][bj][m][0]; *(pg::f32x4*)(dst + bj * 128 + 4) = acc[ai][bj][m][1]; }
                }
            }
    }
};
__device__ __forceinline__ void phase_s5carry(const Ctx& c, int l) {
    float* loc = c.smem;
#pragma unroll 1
    for (int it = c.bid; it < 256; it += c.nblk) {
        const int g = it >> 3, b = (it >> 1) & 3, d = it & 1;
        const int n = c.tid & 63, sgp = c.tid >> 6;
        const int pg_ = (l * 2 + d) * 32 + g;
        const float lr = c.p->in[I_LRE][pg_ * 64 + n], li = c.p->in[I_LIM][pg_ * 64 + n], dt = expf(c.p->in[I_LOGDT][pg_]);
        const float e16 = expf(16.f * lr * dt), Ar = e16 * cosf(16.f * li * dt), Ai = e16 * sinf(16.f * li * dt);
        const float e34 = expf(544.f * lr * dt), Pr = e34 * cosf(544.f * li * dt), Pi = e34 * sinf(544.f * li * dt);
        const float* Eb = cEOUT(c) + ((size_t)g * 1088 + b * 272) * 256 + d * 128 + n;
        float sr = 0.f, si = 0.f;
#pragma unroll 1
        for (int hb = 0; hb < 2; ++hb) {
            float er[17], ei[17];
#pragma unroll
            for (int i = 0; i < 17; ++i) {
                const int q = sgp * 34 + hb * 17 + i;
                const int ch = d == 0 ? q : (q < 16 ? 15 - q : 287 - q);
                er[i] = Eb[ch * 256]; ei[i] = Eb[ch * 256 + 64];
            }
#pragma unroll
            for (int i = 0; i < 17; ++i) { const float tr = Ar * sr - Ai * si + er[i], ti = Ar * si + Ai * sr + ei[i]; sr = tr; si = ti; }
        }
        __syncthreads();
        loc[(sgp * 64 + n) * 2] = sr; loc[(sgp * 64 + n) * 2 + 1] = si;
        __syncthreads();
        float hr = 0.f, hi = 0.f;
        for (int s2 = 0; s2 < sgp; ++s2) { const float tr = Pr * hr - Pi * hi + loc[(s2 * 64 + n) * 2], ti = Pr * hi + Pi * hr + loc[(s2 * 64 + n) * 2 + 1]; hr = tr; hi = ti; }
        bf16_t* Ab = cAY(c) + ((size_t)(g * 1280 + b * 272)) * 512 + 256 + d * 128 + n;
#pragma unroll 1
        for (int hb = 0; hb < 2; ++hb) {
            float er[17], ei[17];
#pragma unroll
            for (int i = 0; i < 17; ++i) {
                const int q = sgp * 34 + hb * 17 + i;
                const int ch = d == 0 ? q : (q < 16 ? 15 - q : 287 - q);
                er[i] = Eb[ch * 256]; ei[i] = Eb[ch * 256 + 64];
            }
#pragma unroll
            for (int i = 0; i < 17; ++i) {
                const int q = sgp * 34 + hb * 17 + i;
                const int ch = d == 0 ? q : (q < 16 ? 15 - q : 287 - q);
                Ab[ch * 512] = f2bf(hr); Ab[ch * 512 + 64] = f2bf(hi);
                const float tr = Ar * hr - Ai * hi + er[i], ti = Ar * hi + Ai * hr + ei[i]; hr = tr; hi = ti;
            }
        }
    }
}
struct S5YEpi {
    static constexpr bool MID = false;
    const bf16_t* AY; bf16_t* G; const float* dvec; int l;
    __device__ __forceinline__ void operator()(const pg::f32x4 (&acc)[2][2][4][2], const pg::Unit& u, int wr, int wc, int fr, int fq) const {
        const int row0 = u.pm * 256 + wr * 64 + fr, col0 = wc * 32 + 8 * fq, g = u.aux;
#pragma unroll
        for (int ai = 0; ai < 2; ++ai)
#pragma unroll
            for (int m = 0; m < 4; ++m) {
                const int r = row0 + ai * 128 + m * 16;
                if (r < 1088) {
                    const int b = r / 272, chunk = r % 272;
#pragma unroll
                    for (int bj = 0; bj < 2; ++bj) {
                        const int cc = col0 + bj * 128, tau = cc >> 4, p0 = cc & 15, pos = chunk * 16 + tau;
                        if (pos < 256 && l == 1) continue;
                        const size_t grow = pos < 256 ? (size_t)(RL + b * 256 + pos) : (size_t)(b * L + pos - 256);
                        float uu[8]; unpack8(*(const pg::u32x4*)(AY + ((size_t)(g * 1280 + r) * 512 + cc)), uu);
                        const pg::f32x4 d0 = *(const pg::f32x4*)(dvec + g * 16 + p0), d1 = *(const pg::f32x4*)(dvec + g * 16 + p0 + 4);
                        pg::f32x4 v0, v1;
#pragma unroll
                        for (int e = 0; e < 4; ++e) {
                            const float x0 = acc[ai][bj][m][0][e] + d0[e] * uu[e], x1 = acc[ai][bj][m][1][e] + d1[e] * uu[4 + e];
                            v0[e] = gelu_tanh_(x0); v1[e] = gelu_tanh_(x1);
                        }
                        *(pg::u32x4*)(G + grow * 512 + g * 16 + p0) = pack8(v0, v1);
                    }
                }
            }
    }
};
struct MixASched {
    RetSched R1; S5Sched SE; const char* BO; const char* KT2; int G, c, n1;
    __device__ __forceinline__ bool next(int i, pg::Unit& u) const {
        int Lx = i * G + c;
        if (Lx < n1) { RetSched t = R1; t.G = 1; t.c = Lx; const bool ok = t.next(0, u); u.pn = 0; u.K = 128; u.ldb = 128; return ok; }
        Lx -= n1;
        if (Lx < 272) {
            u.pm = Lx; u.aux = Lx; u.swap = 0; u.pn = 2; u.K = 256; u.ldb = 256;
            u.a = BO + (size_t)Lx * 128 * 512 * 2; u.b = KT2 + (size_t)Lx * 256 * 256 * 2; return true; }
        Lx -= 272;
        S5Sched t = SE; t.G = 1; t.c = Lx; const bool ok = t.next(0, u); u.pn = 1; u.K = 256; u.ldb = 256; return ok;
    }
    __device__ __forceinline__ unsigned a_off(const pg::Unit& u, int h, int R_, int C) const { return (unsigned)(((h * 128 + R_) * (u.pn ? 512 : 128) + C) * 2); }
    __device__ __forceinline__ bool defer(const pg::Unit&) const { return false; }
    __device__ __forceinline__ bool try_ready(const pg::Unit&) const { return true; }
    __device__ __forceinline__ void wait_ready(const pg::Unit&, int) const {}
    __device__ __forceinline__ void publish(const pg::Unit&, int) const {}
};
struct MixAEpi {
    static constexpr bool MID = false;
    RetU1Epi E1; S5EEpi EE; RetU2Epi E2;
    __device__ __forceinline__ void operator()(const pg::f32x4 (&acc)[2][2][4][2], const pg::Unit& u, int wr, int wc, int fr, int fq) const {
        if (u.pn == 0) E1(acc, u, wr, wc, fr, fq);
        else if (u.pn == 2) E2(acc, u, wr, wc, fr, fq);
        else { pg::Unit v = u; v.pn = 0; EE(acc, v, wr, wc, fr, fq); }
    }
};
__device__ __forceinline__ void phase_mixA(const Ctx& c, int l) {
    MixASched S{RetSched{(const char*)cQP(c), (const char*)cKR(c), 1, 0, 1, l, 128}, S5Sched{(const char*)cAY(c), (const char*)(cPE(c) + (size_t)l * 32 * 256 * 256), 1, 0, 256, 256},
                (const char*)cBO(c), (const char*)cKT2(c), c.nblk, c.bid, (l == 0) ? 272 : 256};
    MixAEpi E{RetU1Epi{cAO(c), c.p->in[I_RETDEC] + l * 8}, S5EEpi{cEOUT(c)}, RetU2Epi{cDST(c)}};
    pg::gemm_phase_var((PG_LAS unsigned char*)c.smem, S, E, opq(c.tid));
}
__device__ __forceinline__ void phase_mixB(const Ctx& c, int l) {
    ret_carry(c, l);
    phase_s5carry(c, l);
    hy_phase(c, l);
}
struct MixCSched {
    RetSched R3; S5Sched SY; int G, c, n3, ldb;
    __device__ __forceinline__ bool next(int i, pg::Unit& u) const {
        const int Lx = i * G + c;
        if (Lx < n3) { RetSched t = R3; t.G = 1; t.c = Lx; const bool ok = t.next(0, u); u.pn = 0; return ok; }
        S5Sched t = SY; t.G = 1; t.c = Lx - n3; const bool ok = t.next(0, u); u.pn = 1; return ok;
    }
    __device__ __forceinline__ unsigned a_off(const pg::Unit&, int h, int R_, int C) const { return (unsigned)(((h * 128 + R_) * 512 + C) * 2); }
};
struct MixCEpi {
    static constexpr bool MID = false;
    RetU3Epi E3; S5YEpi EY;
    __device__ __forceinline__ void operator()(const pg::f32x4 (&acc)[2][2][4][2], const pg::Unit& u, int wr, int wc, int fr, int fq) const {
        if (u.pn == 0) E3(acc, u, wr, wc, fr, fq);
        else { pg::Unit v = u; v.pn = 0; EY(acc, v, wr, wc, fr, fq); }
    }
};
__device__ __forceinline__ void phase_mixC(const Ctx& c, int l) {
    MixCSched S{RetSched{(const char*)cAO(c), (const char*)cBO(c), 1, 0, 3, l, 512}, S5Sched{(const char*)cAY(c), (const char*)(cPY(c) + (size_t)l * 32 * 256 * 512), 1, 0, 512, 512},
                c.nblk, c.bid, (l == 0) ? 272 : 256, 512};
    MixCEpi E{RetU3Epi{cYCAT(c), cZG(c), c.p->in[I_RETGN] + l * 512, (PG_LAS float*)((PG_LAS unsigned char*)c.smem + LDS_SH + 4608)}, S5YEpi{cAY(c), cG(c), c.p->in[I_S5D] + l * 512, l}};
    pg::gemm_phase<false>((PG_LAS unsigned char*)c.smem, 512, S, E, opq(c.tid));
    { const int nu = (l == 0) ? 432 : 416, first = nu - c.nblk;
      if (first > 0 && first < c.nblk) { if (c.bid >= first) { __syncthreads(); hy_transpose(c, l, c.bid - first, c.nblk - first); } }
      else hy_transpose(c, l, c.bid, c.nblk); }
}

struct PlainSched {
    const char* A; const char* Bt; int G, c, nM, nN, lda, K, ldb;
    __device__ __forceinline__ bool next(int i, pg::Unit& u) const {
        const int Lx = i * G + c; if (Lx >= nM * nN) return false;
        pg::static_tile(Lx, nM, nN, u.pm, u.pn);
        u.a = A + (size_t)u.pm * 256 * lda * 2; u.b = Bt + (size_t)u.pn * 256 * K * 2; u.aux = 0; u.swap = 0; return true;
    }
    __device__ __forceinline__ unsigned a_off(const pg::Unit&, int h, int R, int C) const { return (unsigned)(((h * 128 + R) * lda + C) * 2); }
};
__device__ __forceinline__ void st16_wt(const __amdgpu_buffer_rsrc_t rs, unsigned byte_off, const pg::u32x4& v) { __builtin_amdgcn_raw_buffer_store_b128(v, rs, byte_off, 0, 16); }
struct GluEpi {
    static constexpr bool MID = false;
    bf16_t* YCAT;
    __device__ __forceinline__ void operator()(const pg::f32x4 (&acc)[2][2][4][2], const pg::Unit& u, int wr, int wc, int fr, int fq) const {
        const int row0 = u.pm * 256 + wr * 64 + fr, col0 = u.pn * 128 + wc * 32 + 8 * fq;
        const __amdgpu_buffer_rsrc_t rs = __builtin_amdgcn_make_buffer_rsrc(YCAT, 0, R * 1536 * 2, 0x00020000);
#pragma unroll
        for (int ai = 0; ai < 2; ++ai)
#pragma unroll
            for (int m = 0; m < 4; ++m) {
                pg::f32x4 v0, v1;
#pragma unroll
                for (int e = 0; e < 4; ++e) { v0[e] = acc[ai][0][m][0][e] * sigmoidf_(acc[ai][1][m][0][e]); v1[e] = acc[ai][0][m][1][e] * sigmoidf_(acc[ai][1][m][1][e]); }
                st16_wt(rs, (unsigned)(((row0 + ai * 128 + m * 16) * 1536 + 512 + col0) * 2), pack8(v0, v1));
            }
    }
};
struct MergeEpi {
    static constexpr bool MID = true;
    const bf16_t* Z; bf16_t* MERGED;
    __device__ __forceinline__ void mid(pg::f32x4 (&acc)[2][2][4][2], const pg::Unit& u, int t, int wr, int wc, int fr, int fq) const {
        const int nb = (t >> 3) - 1;
        int zz = 0; asm volatile("" : "+v"(zz));
        const int row0 = u.pm * 256 + wr * 64 + fr + zz, col0 = u.pn * 256 + wc * 32 + 8 * fq;
#pragma unroll
        for (int ai = 0; ai < 2; ++ai)
#pragma unroll
            for (int mp = 0; mp < 2; ++mp) {
                pg::u32x4 ra[2][2], rb[2][2];
#pragma unroll
                for (int mi = 0; mi < 2; ++mi)
#pragma unroll
                    for (int bj = 0; bj < 2; ++bj) {
                        const bf16_t* gp = Z + (size_t)(row0 + ai * 128 + (mp * 2 + mi) * 16) * 3072 + nb * 1024 + col0 + bj * 128;
                        ra[mi][bj] = *(const pg::u32x4*)gp; rb[mi][bj] = *(const pg::u32x4*)(gp + 1024);
                    }
#pragma unroll
                for (int mi = 0; mi < 2; ++mi)
#pragma unroll
                    for (int bj = 0; bj < 2; ++bj) {
                        const int m = mp * 2 + mi;
                        float ga[8], gb[8]; unpack8(ra[mi][bj], ga); unpack8(rb[mi][bj], gb);
#pragma unroll
                        for (int e = 0; e < 4; ++e) { acc[ai][bj][m][0][e] *= ga[e] * __builtin_amdgcn_rcpf(gb[e]); acc[ai][bj][m][1][e] *= ga[4 + e] * __builtin_amdgcn_rcpf(gb[4 + e]); }
                    }
                asm volatile("" ::: "memory");
            }
    }
    __device__ __forceinline__ void operator()(const pg::f32x4 (&acc)[2][2][4][2], const pg::Unit& u, int wr, int wc, int fr, int fq) const {
        const int row0 = u.pm * 256 + wr * 64 + fr, col0 = u.pn * 256 + wc * 32 + 8 * fq;
        const __amdgpu_buffer_rsrc_t rs = __builtin_amdgcn_make_buffer_rsrc(MERGED, 0, R * 1024 * 2, 0x00020000);
#pragma unroll
        for (int ai = 0; ai < 2; ++ai)
#pragma unroll
            for (int mp = 0; mp < 2; ++mp) {
                pg::u32x4 rg[2][2];
#pragma unroll
                for (int mi = 0; mi < 2; ++mi)
#pragma unroll
                    for (int bj = 0; bj < 2; ++bj) rg[mi][bj] = *(const pg::u32x4*)(Z + (size_t)(row0 + ai * 128 + (mp * 2 + mi) * 16) * 3072 + 2 * 1024 + col0 + bj * 128);
#pragma unroll
                for (int mi = 0; mi < 2; ++mi)
#pragma unroll
                    for (int bj = 0; bj < 2; ++bj) {
                        const int m = mp * 2 + mi;
                        float g[8]; unpack8(rg[mi][bj], g);
                        pg::f32x4 v0 = acc[ai][bj][m][0], v1 = acc[ai][bj][m][1];
#pragma unroll
                        for (int e = 0; e < 4; ++e) { v0[e] *= g[e]; v1[e] *= g[4 + e]; }
                        st16_wt(rs, (unsigned)(((row0 + ai * 128 + m * 16) * 1024 + col0 + bj * 128) * 2), pack8(v0, v1));
                    }
                asm volatile("" ::: "memory");
            }
    }
};
struct OutprojEpi {
    static constexpr bool MID = false;
    float* X; float* XC; const float* MODL;
    __device__ __forceinline__ void operator()(const pg::f32x4 (&acc)[2][2][4][2], const pg::Unit& u, int wr, int wc, int fr, int fq) const {
        const int row0 = u.pm * 256 + wr * 64 + fr, col0 = u.pn * 256 + wc * 32 + 8 * fq;
#pragma unroll
        for (int ai = 0; ai < 2; ++ai)
#pragma unroll
            for (int m = 0; m < 4; ++m) {
                const int row = row0 + ai * 128 + m * 16;
                float* dst = row < RL ? X + (size_t)row * D : XC + (size_t)(row - RL) * D;
                const float* gate = MODL + (size_t)(row < RL ? row / L : 4) * 6144 + 2048;
#pragma unroll
                for (int bj = 0; bj < 2; ++bj)
#pragma unroll
                    for (int n = 0; n < 2; ++n) {
                        const int col = col0 + bj * 128 + 4 * n;
                        pg::f32x4 v = *(pg::f32x4*)(dst + col); const pg::f32x4 gg = *(const pg::f32x4*)(gate + col);
                        v += gg * acc[ai][bj][m][n];
                        *(pg::f32x4*)(dst + col) = v;
                    }
            }
    }
};
struct GmoSched {
    const char *Gp, *GLUT, *YC, *BRT, *MG, *OUTT; unsigned* cnt; int G, c, nM, rev;
    __device__ __forceinline__ bool next(int i, pg::Unit& u) const {
        const int nU = nM * 4; int Lx, st;
        if (rev == 2) {
            const int lo = 240 + ((c - 240) & 3) + 8 * ((c - 240) >> 2);
            if (i == 0) { st = 0; Lx = c; }
            else if (i == 1) { if (c >= 240) { st = 0; Lx = 256 + (c - 240); } else { st = 1; Lx = c; } }
            else if (i == 2) { if (c >= 240) { st = 1; Lx = lo; } else if (c < 16) { st = 1; Lx = 244 + (c & 3) + 8 * (c >> 2); } else { st = 2; Lx = c - 16; } }
            else if (i == 3) { if (c >= 240) { st = 2; Lx = lo; } else if (c >= 16 && c < 32) { st = 2; Lx = 244 + ((c - 16) & 3) + 8 * ((c - 16) >> 2); } else if (c >= 32 && c < 48) { st = 2; Lx = 224 + (c - 32); } else return false; }
            else return false;
        } else {
            Lx = i * G + ((rev && (i & 1)) ? G - 1 - c : c);
            st = Lx / nU; if (st > 2) return false;
            Lx -= st * nU;
        }
        const int nctx = (nM - 64) * 4;
        if (Lx < nctx) { u.pm = 64 + Lx % (nM - 64 > 0 ? nM - 64 : 1); u.pn = Lx / (nM - 64 > 0 ? nM - 64 : 1); }
        else { const int j = Lx - nctx, x = j & 7, s = j >> 3; u.pm = x * 8 + (s >> 2); u.pn = s & 3; }
        u.aux = st; u.swap = 0;
        if (st == 0) { u.a = Gp + (size_t)u.pm * 256 * 512 * 2; u.b = GLUT + (size_t)u.pn * 256 * 512 * 2; u.K = 512; u.ldb = 512; }
        else if (st == 1) { u.a = YC + (size_t)u.pm * 256 * 1536 * 2; u.b = BRT + (size_t)u.pn * 256 * 1536 * 2; u.K = 1536; u.ldb = 1536; }
        else { u.a = MG + (size_t)u.pm * 256 * 1024 * 2; u.b = OUTT + (size_t)u.pn * 256 * 1024 * 2; u.K = 1024; u.ldb = 1024; }
        return true;
    }
    __device__ __forceinline__ unsigned a_off(const pg::Unit& u, int h, int R_, int C) const { return (unsigned)(((h * 128 + R_) * u.K + C) * 2); }
    __device__ __forceinline__ bool defer(const pg::Unit& u) const { return u.aux != 0; }
    __device__ __forceinline__ bool try_ready(const pg::Unit& u) const {
        if ((unsigned)__builtin_amdgcn_readfirstlane((int)__hip_atomic_load(cnt + (u.aux - 1) * 128 + u.pm, __ATOMIC_RELAXED, __HIP_MEMORY_SCOPE_AGENT)) < 4u) return false;
        return true;
    }
    __device__ __forceinline__ void wait_ready(const pg::Unit& u, int tid) const {
        if (u.aux == 0) return;
        if (tid < 64) {
            unsigned sp = 0;
            while ((unsigned)__builtin_amdgcn_readfirstlane((int)__hip_atomic_load(cnt + (u.aux - 1) * 128 + u.pm, __ATOMIC_RELAXED, __HIP_MEMORY_SCOPE_AGENT)) < 4u) { __builtin_amdgcn_s_sleep(2); if (++sp > (1u << 22)) break; }
        }
        asm volatile("" ::: "memory"); __builtin_amdgcn_s_barrier(); asm volatile("" ::: "memory");
    }
    __device__ __forceinline__ void publish(const pg::Unit& u, int tid) const {
        if (u.aux == 2) return;
        asm volatile("s_waitcnt vmcnt(0)" ::: "memory");
        __builtin_amdgcn_s_barrier();
        if (tid == 0) (void)__hip_atomic_fetch_add(cnt + u.aux * 128 + u.pm, 1u, __ATOMIC_RELAXED, __HIP_MEMORY_SCOPE_AGENT);
    }
};
struct GmoEpi {
    static constexpr bool MID = true;
    GluEpi EG; MergeEpi EM; OutprojEpi EO;
    __device__ __forceinline__ bool has_mid(const pg::Unit& u) const { return u.aux == 1; }
    __device__ __forceinline__ void mid(pg::f32x4 (&acc)[2][2][4][2], const pg::Unit& u, int t, int wr, int wc, int fr, int fq) const { EM.mid(acc, u, t, wr, wc, fr, fq); }
    __device__ __forceinline__ void operator()(const pg::f32x4 (&acc)[2][2][4][2], const pg::Unit& u, int wr, int wc, int fr, int fq) const {
        if (u.aux == 0) EG(acc, u, wr, wc, fr, fq);
        else if (u.aux == 1) EM(acc, u, wr, wc, fr, fq);
        else EO(acc, u, wr, wc, fr, fq);
    }
};
__device__ __forceinline__ void phase_fin(const Ctx& c, int l) {
    ret_finalize(c, l);
}
__device__ __forceinline__ void phase_gmo(const Ctx& c, int l) {
    const int nM = (l == 0) ? 68 : 64;
    GmoSched S{(const char*)cG(c), (const char*)cGLUT(c), (const char*)cYCAT(c), (const char*)cBRT(c), (const char*)cMERGED(c), (const char*)cOUTT(c),
               (unsigned*)(c.ws + OFF_CTL) + 12288 + l * 256, c.nblk, c.bid, nM, l == 0 ? (c.nblk == 256 ? 2 : 1) : 0};
    GmoEpi E{GluEpi{cYCAT(c)}, MergeEpi{cZGATE(c), cMERGED(c)}, OutprojEpi{c.X, cXC(c), cMOD(c) + (size_t)l * 5 * 6144}};
    const bool split = (l == 1 && c.nblk == 256);
    if (split && (c.bid & 7) < 4) { phase_convert(c, l, true, c.bid, c.nblk); __syncthreads(); }
    pg::gemm_phase_var((PG_LAS unsigned char*)c.smem, S, E, opq(c.tid));
    if (split) { if ((c.bid & 7) >= 4) phase_convert(c, l, true, c.bid, c.nblk); return; }
    if (l == 0 && c.nblk == 256) { if (c.bid >= 48 && c.bid < 240) phase_convert(c, l, true, c.bid - 48, 192); }
    else phase_convert(c, l, true);
}

__device__ __forceinline__ void moe_prefix(const Ctx& c, int l, int* sh) {
    __syncthreads();
    if (c.tid == 0) {
        int tp = 0;
        for (int e = 0; e < 32; ++e) { const int n = cCNT(c)[(l * 32 + e) * 64]; sh[e] = n; sh[32 + e] = tp; tp += (n + 255) >> 8; }
        sh[64] = tp;
    }
    __syncthreads();
}
struct MoeUpEpi {
    static constexpr bool MID = false;
    bf16_t* HID;
    __device__ __forceinline__ void operator()(const pg::f32x4 (&acc)[2][2][4][2], const pg::Unit& u, int wr, int wc, int fr, int fq) const {
        const int row0 = u.pm * 256 + wr * 64 + fr, col0 = u.pn * 128 + wc * 32 + 8 * fq;
        const __amdgpu_buffer_rsrc_t rs = __builtin_amdgcn_make_buffer_rsrc(HID, 0, 42752 * 512 * 2, 0x00020000);
#pragma unroll
        for (int ai = 0; ai < 2; ++ai)
#pragma unroll
            for (int m = 0; m < 4; ++m) {
                pg::f32x4 v0, v1;
#pragma unroll
                for (int e = 0; e < 4; ++e) { v0[e] = siluf_(acc[ai][0][m][0][e]) * acc[ai][1][m][0][e]; v1[e] = siluf_(acc[ai][0][m][1][e]) * acc[ai][1][m][1][e]; }
                st16_wt(rs, (unsigned)(((row0 + ai * 128 + m * 16) * 512 + col0) * 2), pack8(v0, v1));
            }
    }
};
struct MoeDnEpi {
    static constexpr bool MID = false;
    bf16_t* YBUF;
    __device__ __forceinline__ void operator()(const pg::f32x4 (&acc)[2][2][4][2], const pg::Unit& u, int wr, int wc, int fr, int fq) const {
        const int row0 = u.pm * 256 + wr * 64 + fr, col0 = u.pn * 256 + wc * 32 + 8 * fq;
#pragma unroll
        for (int ai = 0; ai < 2; ++ai)
#pragma unroll
            for (int m = 0; m < 4; ++m)
#pragma unroll
                for (int bj = 0; bj < 2; ++bj)
                    *(pg::u32x4*)(YBUF + (size_t)(row0 + ai * 128 + m * 16) * 1024 + col0 + bj * 128) = pack8(acc[ai][bj][m][0], acc[ai][bj][m][1]);
    }
};
struct MoeSched {
    const char* H; const char* UPT; const char* HID; const char* DNT; const int* SLOTTOK; const int* sh; unsigned* rdy; int G, c;
    __device__ __forceinline__ bool next(int i, pg::Unit& u) const {
        const int NU = sh[64] * 4; int Lx = i * G + c;
        const int ty = Lx >= NU ? 1 : 0; if (ty) Lx -= NU;
        if (Lx >= NU) return false;
        const int mtg = Lx >> 2; int e = 0;
#pragma unroll 1
        while (e < 31 && sh[32 + e + 1] <= mtg) ++e;
        u.pm = mtg; u.pn = Lx & 3; u.swap = ty;
        if (ty == 0) { u.aux = e | ((mtg - sh[32 + e]) << 8); u.a = H; u.b = UPT + ((size_t)e * 1024 + u.pn * 256) * 1024 * 2; u.K = 1024; u.ldb = 1024; }
        else { u.aux = e; u.a = HID + (size_t)mtg * 256 * 512 * 2; u.b = DNT + ((size_t)e * 1024 + u.pn * 256) * 512 * 2; u.K = 512; u.ldb = 512; }
        return true;
    }
    __device__ __forceinline__ unsigned a_off(const pg::Unit& u, int h, int R_, int C) const {
        if (u.swap) return (unsigned)(((h * 128 + R_) * 512 + C) * 2);
        const int e = u.aux & 255, pos = (u.aux >> 8) * 256 + h * 128 + R_;
        const int tok = pos < sh[e] ? (SLOTTOK[(size_t)e * SLOTCAP + pos] >> 1) : 0;
        return (unsigned)((tok * D + C) * 2);
    }
    __device__ __forceinline__ bool defer(const pg::Unit& u) const { return u.swap != 0; }
    __device__ __forceinline__ bool try_ready(const pg::Unit& u) const {
        if ((unsigned)__builtin_amdgcn_readfirstlane((int)__hip_atomic_load(rdy + u.pm, __ATOMIC_RELAXED, __HIP_MEMORY_SCOPE_AGENT)) < 4u) return false;
        return true;
    }
    __device__ __forceinline__ void wait_ready(const pg::Unit& u, int tid) const {
        if (!u.swap) return;
        if (tid < 64) {
            unsigned sp = 0;
            while ((unsigned)__builtin_amdgcn_readfirstlane((int)__hip_atomic_load(rdy + u.pm, __ATOMIC_RELAXED, __HIP_MEMORY_SCOPE_AGENT)) < 4u) { __builtin_amdgcn_s_sleep(2); if (++sp > (1u << 22)) break; }
        }
        asm volatile("" ::: "memory"); __builtin_amdgcn_s_barrier(); asm volatile("" ::: "memory");
    }
    __device__ __forceinline__ void publish(const pg::Unit& u, int tid) const {
        if (u.swap) return;
        asm volatile("s_waitcnt vmcnt(0)" ::: "memory");
        __builtin_amdgcn_s_barrier();
        if (tid == 0) (void)__hip_atomic_fetch_add(rdy + u.pm, 1u, __ATOMIC_RELAXED, __HIP_MEMORY_SCOPE_AGENT);
    }
};
struct MoeEpi {
    static constexpr bool MID = false;
    MoeUpEpi EU; MoeDnEpi ED;
    __device__ __forceinline__ void operator()(const pg::f32x4 (&acc)[2][2][4][2], const pg::Unit& u, int wr, int wc, int fr, int fq) const {
        if (u.swap) ED(acc, u, wr, wc, fr, fq); else EU(acc, u, wr, wc, fr, fq);
    }
};
__device__ __forceinline__ void phase_moe(const Ctx& c, int l) {
    int* sh = (int*)((unsigned char*)c.smem + LDS_SH);
    moe_prefix(c, l, sh);
    MoeSched S{(const char*)cH(c), (const char*)cUPT(c), (const char*)cHID(c), (const char*)cDNT(c), cSLOTTOK(c), sh, (unsigned*)(c.ws + OFF_CTL) + 13312 + l * 256, c.nblk, c.bid};
    MoeEpi E{MoeUpEpi{cHID(c)}, MoeDnEpi{cYBUF(c)}};
    pg::gemm_phase_var((PG_LAS unsigned char*)c.smem, S, E, opq(c.tid));
}
__device__ __forceinline__ void moe_prefix(const Ctx& c, int l, int* sh);
__device__ __forceinline__ void phase_combine(const Ctx& c, int l, const bool last) {
    int* sh = (int*)((unsigned char*)c.smem + LDS_SH);
    moe_prefix(c, l, sh);
    if (!last) phase_convert(c, l + 1, false);
    const int nrows = (l == 0) ? R : RL;
    const int gw = c.bid * 8 + c.wave, nw = c.nblk * 8;
    for (int r = gw; r < nrows; r += nw) {
        const int e0 = cROUTE_E(c)[r * 2], e1 = cROUTE_E(c)[r * 2 + 1];
        const float w0 = cROUTE_W(c)[r * 2], w1 = cROUTE_W(c)[r * 2 + 1];
        const bf16_t* y0p = cYBUF(c) + (size_t)(sh[32 + e0] * 256 + cSLOTPOS(c)[r * 2]) * 1024;
        const bf16_t* y1p = cYBUF(c) + (size_t)(sh[32 + e1] * 256 + cSLOTPOS(c)[r * 2 + 1]) * 1024;
        float* xr = r < RL ? c.X + (size_t)r * D : cXC(c) + (size_t)(r - RL) * D;
        const float* gg = cMOD(c) + (size_t)(l * 5 + (r < RL ? r / L : 4)) * 6144 + 5120;
        float y[16];
#pragma unroll
        for (int j = 0; j < 4; ++j) {
            const int d = (j * 64 + c.lane) * 4;
            const float4 xv = *(const float4*)(xr + d), g4 = *(const float4*)(gg + d);
            const uint2 a = *(const uint2*)(y0p + d), b = *(const uint2*)(y1p + d);
            y[j * 4 + 0] = xv.x + g4.x * (w0 * __uint_as_float(a.x << 16) + w1 * __uint_as_float(b.x << 16));
            y[j * 4 + 1] = xv.y + g4.y * (w0 * __uint_as_float(a.x & 0xffff0000u) + w1 * __uint_as_float(b.x & 0xffff0000u));
            y[j * 4 + 2] = xv.z + g4.z * (w0 * __uint_as_float(a.y << 16) + w1 * __uint_as_float(b.y << 16));
            y[j * 4 + 3] = xv.w + g4.w * (w0 * __uint_as_float(a.y & 0xffff0000u) + w1 * __uint_as_float(b.y & 0xffff0000u));
        }
        if (!last) {
#pragma unroll
            for (int j = 0; j < 4; ++j) *(float4*)(xr + (j * 64 + c.lane) * 4) = make_float4(y[j * 4], y[j * 4 + 1], y[j * 4 + 2], y[j * 4 + 3]);
            norm_apply(c, l + 1, r, 0, y);
#pragma unroll
            for (int j = 0; j < 4; ++j) store_bf4(cH(c) + (size_t)r * D + (j * 64 + c.lane) * 4, y[j * 4], y[j * 4 + 1], y[j * 4 + 2], y[j * 4 + 3]);
        } else {
            float ss = 0.f;
#pragma unroll
            for (int i = 0; i < 16; ++i) ss += y[i] * y[i];
            ss = wave_sum(ss, c.lane);
            float rinv = rsqrtf(ss * (1.0f / 1024.0f) + 1e-6f);
#pragma unroll
            for (int j = 0; j < 4; ++j) {
                const float4 fg = *(const float4*)(c.p->in[I_FNG] + (j * 64 + c.lane) * 4);
                *(float4*)(xr + (j * 64 + c.lane) * 4) = make_float4(y[j * 4] * rinv * fg.x, y[j * 4 + 1] * rinv * fg.y, y[j * 4 + 2] * rinv * fg.z, y[j * 4 + 3] * rinv * fg.w);
            }
        }
    }
}

#define XB_TMO      128
#define XB_XCNT(j)  (256  + 64 * (j))
#define XB_XSUB(j)  (1280 + 64 * (j))
#define XB_XGEN(j)  (2304 + 64 * (j))
#define XB_TOP      3328
#define XB_TOPGEN   3392
#define XCD_BAR_WORDS 3456
#define XB_SPIN_CAP (1u << 18)
#define LAS __attribute__((address_space(3)))
__device__ __forceinline__ unsigned xb_ld(unsigned* p)              { return __hip_atomic_load(p, __ATOMIC_RELAXED, __HIP_MEMORY_SCOPE_AGENT); }
__device__ __forceinline__ unsigned xb_add(unsigned* p, unsigned v) { return __hip_atomic_fetch_add(p, v, __ATOMIC_RELAXED, __HIP_MEMORY_SCOPE_AGENT); }
__device__ __forceinline__ unsigned xb_xcc_id() { return (unsigned)__builtin_amdgcn_s_getreg((3 << 11) | 20) & 0xFu; }
#define XB_SPIN(cond, bar) do { unsigned _sp = 0; while (cond) { __builtin_amdgcn_s_sleep(1); \
    if ((++_sp & 255u) == 0u) { if (xb_ld(&(bar)[XB_TMO])) break; if (_sp > XB_SPIN_CAP) { atomicAdd(&(bar)[XB_TMO], 1u); break; } } } } while (0)
struct XcdBarrier { unsigned* bar; unsigned x; volatile LAS unsigned* st; };
__device__ __forceinline__ XcdBarrier xcd_barrier_post(unsigned* bar, volatile LAS unsigned* st, const bool t0) {
    XcdBarrier b; b.bar = bar; b.x = xb_xcc_id(); b.st = st;
    if (t0) (void)xb_add(&bar[XB_XCNT(b.x)], 1u);
    return b;
}
__device__ __forceinline__ void xcd_barrier_complete(unsigned* bar, unsigned x, unsigned& nloc, unsigned& nx) {
    const unsigned G = gridDim.x * gridDim.y * gridDim.z;
    unsigned sum, cnt, mine, sp = 0u;
    for (;;) {
        sum = 0u; cnt = 0u; mine = 0u;
#pragma unroll
        for (unsigned j = 0; j < 16; ++j) { const unsigned c = xb_ld(&bar[XB_XCNT(j)]); sum += c; cnt += (c > 0u) ? 1u : 0u; mine = (j == x) ? c : mine; }
        if (sum == G) break;
        __builtin_amdgcn_s_sleep(1);
        if ((++sp & 255u) == 0u) { if (xb_ld(&bar[XB_TMO])) break; if (sp > XB_SPIN_CAP) { atomicAdd(&bar[XB_TMO], 1u); break; } }
    }
    nloc = mine > 0u ? mine : 1u; nx = cnt > 0u ? cnt : 1u;
}
__device__ __forceinline__ void xcd_barrier(const XcdBarrier& b, const bool t0) {
    asm volatile("s_waitcnt vmcnt(0)" ::: "memory");
    __syncthreads();
    if (t0) {
        unsigned* bar = b.bar;
        __builtin_amdgcn_s_waitcnt(0);
        unsigned nloc = b.st[0], nx = b.st[1];
        if (nloc == 0u) { xcd_barrier_complete(bar, b.x, nloc, nx); b.st[0] = nloc; b.st[1] = nx; }
        const unsigned old = xb_add(&bar[XB_XSUB(b.x)], 1u);
        const unsigned gen = old / nloc;
        if (old + 1u == (gen + 1u) * nloc) {
            __builtin_amdgcn_fence(__ATOMIC_RELEASE, "agent");
            asm volatile("s_waitcnt vmcnt(0)" ::: "memory");
            asm volatile("buffer_inv sc1" ::: "memory");
            const unsigned og = xb_add(&bar[XB_TOP], 1u);
            const unsigned tg = og / nx;
            if (og + 1u == (tg + 1u) * nx) {
#pragma unroll
                for (unsigned j = 0; j < 16; ++j) xb_add(&bar[XB_XGEN(j)], 1u);
            } else { XB_SPIN(xb_ld(&bar[XB_XGEN(b.x)]) == gen, bar); asm volatile("s_waitcnt vmcnt(0)" ::: "memory"); }
            asm volatile("" ::: "memory");
        } else {
            asm volatile("buffer_inv sc1" ::: "memory");
            XB_SPIN(xb_ld(&bar[XB_XGEN(b.x)]) == gen, bar);
            asm volatile("s_waitcnt vmcnt(0)" ::: "memory");
        }
    }
    __syncthreads();
}

__global__ void __launch_bounds__(NT) mega(Params p) {
    extern __shared__ __attribute__((aligned(16))) unsigned char lds_raw[];
    Ctx c;
    cg::grid_group grid = cg::this_grid();
    volatile LAS unsigned* xst = (volatile LAS unsigned*)((LAS unsigned char*)lds_raw + (LDS_BYTES - 16));
    const int wave_s = __builtin_amdgcn_readfirstlane((int)threadIdx.x >> 6);
#define LANEID() ([&]() { int z_ = 0; asm volatile("" : "+s"(z_)); return (int)__builtin_amdgcn_mbcnt_hi(~0u, __builtin_amdgcn_mbcnt_lo(~0u, (unsigned)z_)); }())
#define T0 (wave_s == 0 && LANEID() == 0)
    if (wave_s == 0 && LANEID() < 4) xst[LANEID()] = 0u;
    __syncthreads();
    const XcdBarrier xbar = xcd_barrier_post((unsigned*)(p.ws + OFF_CTL) + 8192, xst, T0);
#define OPAQUE() do { int zo = 0; asm volatile("" : "+s"(zo)); int zv = 0; asm volatile("" : "+v"(zv)); \
        c.p = (KParams)((const __attribute__((address_space(4))) unsigned char*)__builtin_amdgcn_kernarg_segment_ptr() + zo); \
        c.ws = p.ws + zo; c.X = p.out + zo; c.smem = (float*)(lds_raw + zo); \
        c.tid = wave_s * 64 + LANEID() + zv; c.lane = c.tid & 63; c.wave = __builtin_amdgcn_readfirstlane(c.tid >> 6); c.bid = (int)blockIdx.x + zo; c.nblk = (int)gridDim.x + zo; } while (0)
#define PH(k, call) { OPAQUE(); call; if ((k) + 1 < NPHASE) { if ((k) == 0) grid.sync(); else xcd_barrier(xbar, T0); } }
    PH(0, phase_init(c))
    PH(1, phase_norm1(c, 0))
#define LAYER(l, b) \
    PH(b + 0, phase_inproj(c, l)) PH(b + 1, phase_mixA(c, l)) PH(b + 2, phase_mixB(c, l)) PH(b + 3, phase_mixC(c, l)) PH(b + 4, phase_gmo(c, l)) \
    PH(b + 5, phase_norm2_route(c, l)) PH(b + 6, phase_moe(c, l))
    LAYER(0, 2)
    PH(9, phase_combine(c, 0, false))
    LAYER(1, 10)
    PH(17, phase_combine(c, 1, true))
}

extern "C" void kernel_launch(void* const* d_in, const int* in_sizes, int n_in, void* d_out, int out_size, void* d_ws, size_t ws_size, hipStream_t stream) {
    static int grid = 0;
    if (grid == 0) {
        if (n_in != N_IN || out_size != RL * D || ws_size < WS_NEED) { fprintf(stderr, "kernel_launch: unexpected shapes n_in %d out %d ws %zu\n", n_in, out_size, ws_size); grid = -1; return; }
        int dev = 0, cus = 0, per_cu = 0;
        hipGetDevice(&dev); hipDeviceGetAttribute(&cus, hipDeviceAttributeMultiprocessorCount, dev);
        hipFuncSetAttribute((const void*)mega, hipFuncAttributeMaxDynamicSharedMemorySize, LDS_BYTES);
        hipOccupancyMaxActiveBlocksPerMultiprocessor(&per_cu, (const void*)mega, NT, LDS_BYTES);
        if (per_cu < 1) { fprintf(stderr, "kernel_launch: occupancy query says %d\n", per_cu); grid = -1; return; }
        grid = cus;
    }
    if (grid < 0) return;
    if (hipMemsetAsync((unsigned char*)d_ws + OFF_CTL, 0, 65536, stream) != hipSuccess) { fprintf(stderr, "kernel_launch: memset failed\n"); return; }
    Params p{};
    for (int i = 0; i < N_IN; ++i) p.in[i] = (const float*)d_in[i];
    p.out = (float*)d_out; p.ws = (unsigned char*)d_ws;
    void* args[] = {&p};
    hipError_t e = hipLaunchCooperativeKernel((const void*)mega, dim3(grid), dim3(NT), args, LDS_BYTES, stream);
    if (e != hipSuccess) fprintf(stderr, "cooperative launch failed: %s\n", hipGetErrorString(e));
}
```

```cpp
#include <hip/hip_runtime.h>
#include <hip/hip_cooperative_groups.h>
#include <cstdio>
#include <cstdint>
namespace cg = cooperative_groups;


typedef unsigned short bf16_t;
constexpr int NB = 4, L = 4096, LC = 256, D = 1024;
constexpr int RL = NB * L, RC = NB * LC, R = RL + RC;
constexpr int INC = 7168;
constexpr int COL_K = 512, COL_V = 1024, COL_G = 1536, COL_S5 = 2048, COL_HY = 2560, COL_GATE = 4096;
constexpr int NEXP = 32, MOEH = 512, SLOTCAP = R;
constexpr int NT = 512;
constexpr int NPHASE = 18;
constexpr int LDS_BYTES = 147456;

constexpr size_t MiB = 1u << 20;
constexpr size_t OFF_CTL = 0;
constexpr size_t OFF_XC = 1 * MiB;
constexpr size_t OFF_MOD = 5 * MiB;
constexpr size_t OFF_FILT = 6 * MiB;
constexpr size_t OFF_FILTC = 22 * MiB;
constexpr size_t OFF_ROUTE_E = 23 * MiB;
constexpr size_t OFF_ROUTE_W = 23 * MiB + 256 * 1024;
constexpr size_t OFF_SLOTPOS = 23 * MiB + 512 * 1024;
constexpr size_t OFF_SLOTTOK = 24 * MiB;
constexpr size_t OFF_H = 27 * MiB;
constexpr size_t OFF_MERGED = OFF_H;
constexpr size_t OFF_EOUT = OFF_H;
constexpr size_t OFF_YCAT = 61 * MiB;
constexpr size_t OFF_DST = OFF_YCAT;
constexpr size_t OFF_QP = 112 * MiB;
constexpr size_t OFF_KR = 129 * MiB;
constexpr size_t OFF_YHYT = OFF_KR;
constexpr size_t OFF_YHYTC = OFF_KR + 16 * MiB;
constexpr size_t OFF_AO = 146 * MiB;
constexpr size_t OFF_KT2 = 214 * MiB;
constexpr size_t OFF_BO = 248 * MiB;
constexpr size_t OFF_HID = OFF_AO;
constexpr size_t OFF_YBUF = OFF_AO + 42 * MiB;
constexpr size_t OFF_ZG = 283 * MiB;
constexpr size_t OFF_AY = 300 * MiB;
constexpr size_t OFF_ZHYT = 340 * MiB;
constexpr size_t OFF_ZHYTC = OFF_ZHYT + 48 * MiB;
constexpr size_t OFF_G = OFF_ZHYT;
constexpr size_t OFF_OR = OFF_ZHYT + 17 * MiB;
constexpr size_t OFF_ZGATE = 391 * MiB;
constexpr size_t OFF_UP_T = 276 * MiB;
constexpr size_t OFF_DN_T = OFF_QP;
constexpr size_t OFF_W = 493 * MiB;
constexpr size_t OFF_WIN_T = OFF_W;
constexpr size_t OFF_GLU_T = OFF_W + 14 * MiB;
constexpr size_t OFF_BR_T = OFF_W + 15 * MiB;
constexpr size_t OFF_OUT_T = OFF_W + 18 * MiB;
constexpr size_t OFF_PE = 513 * MiB;
constexpr size_t OFF_PY = 521 * MiB;
constexpr size_t WS_NEED = 537 * MiB;
constexpr int LDS_SH = 131072;

enum { I_X = 0, I_C, I_CTX, I_CCTX, I_WMOD, I_BMOD, I_N1G, I_N2G, I_WIN, I_RETDEC, I_RETGN, I_LRE, I_LIM, I_LOGDT, I_BRE, I_BIM, I_CRE, I_CIM,
       I_S5D, I_GLU1, I_GLU2, I_HYSW, I_HYSB, I_HYW1, I_HYB1, I_HYW2, I_HYB2, I_HYW3, I_HYFREQ, I_HYBIAS, I_WBR, I_WOUT, I_MWG, I_MBG, I_MWE, I_MBE,
       I_MW1, I_MW3, I_MW2, I_FNG, N_IN };

struct Params { const float* in[N_IN]; float* out; unsigned char* ws; };

__device__ __forceinline__ float bf2f(bf16_t v) { return __uint_as_float(((unsigned)v) << 16); }
__device__ __forceinline__ bf16_t f2bf(float f) { unsigned u = __float_as_uint(f); return (bf16_t)((u + 0x7fffu + ((u >> 16) & 1u)) >> 16); }
__device__ __forceinline__ float sigmoidf_(float x) { return __builtin_amdgcn_rcpf(1.f + __expf(-x)); }
__device__ __forceinline__ float siluf_(float x) { return x * __builtin_amdgcn_rcpf(1.f + __expf(-x)); }
__device__ __forceinline__ float gelu_tanh_(float x) {
    const float z = 0.7978845608028654f * (x + 0.044715f * x * x * x);
    return x * (1.f - __builtin_amdgcn_rcpf(1.f + __expf(2.f * z)));
}
__device__ __forceinline__ float shx(float v, int mask, int lane) { return __int_as_float(__builtin_amdgcn_ds_bpermute((lane ^ mask) << 2, __float_as_int(v))); }
__device__ __forceinline__ float shl_(float v, int src) { return __int_as_float(__builtin_amdgcn_ds_bpermute(src << 2, __float_as_int(v))); }
__device__ __forceinline__ float wave_sum_dpp(float v) {
    int x = __float_as_int(v);
    x = __float_as_int(__int_as_float(x) + __int_as_float(__builtin_amdgcn_update_dpp(0, x, 0xB1, 0xF, 0xF, true)));
    x = __float_as_int(__int_as_float(x) + __int_as_float(__builtin_amdgcn_update_dpp(0, x, 0x4E, 0xF, 0xF, true)));
    x = __float_as_int(__int_as_float(x) + __int_as_float(__builtin_amdgcn_update_dpp(0, x, 0x141, 0xF, 0xF, true)));
    x = __float_as_int(__int_as_float(x) + __int_as_float(__builtin_amdgcn_update_dpp(0, x, 0x140, 0xF, 0xF, true)));
    x = __float_as_int(__int_as_float(x) + __int_as_float(__builtin_amdgcn_update_dpp(0, x, 0x142, 0xA, 0xF, true)));
    x = __float_as_int(__int_as_float(x) + __int_as_float(__builtin_amdgcn_update_dpp(0, x, 0x143, 0xC, 0xF, true)));
    return __int_as_float(__builtin_amdgcn_readlane(x, 63));
}
__device__ __forceinline__ float wave_sum(float v, int lane) {
#pragma unroll
    for (int o = 32; o >= 1; o >>= 1) v += shx(v, o, lane);
    return v;
}

typedef const __attribute__((address_space(4))) Params* KParams;
struct Ctx {
    KParams p; unsigned char* ws; float* X; float* smem; int tid, lane, wave, bid, nblk;
};
__device__ __forceinline__ int opq(int v) { int z = 0; asm volatile("" : "+v"(z)); return v + z; }
#define WSF(name, type, off) __device__ __forceinline__ type* name(const Ctx& c) { return (type*)(c.ws + (off)); }
WSF(cPET, float, OFF_MOD + 512 * 1024) WSF(cXC, float, OFF_XC) WSF(cMOD, float, OFF_MOD) WSF(cFILT, bf16_t, OFF_FILT) WSF(cFILTC, bf16_t, OFF_FILTC) WSF(cYHYT, bf16_t, OFF_YHYT) WSF(cYHYTC, bf16_t, OFF_YHYTC) WSF(cROUTE_E, int, OFF_ROUTE_E) WSF(cROUTE_W, float, OFF_ROUTE_W)
WSF(cSLOTPOS, int, OFF_SLOTPOS) WSF(cSLOTTOK, int, OFF_SLOTTOK) WSF(cH, bf16_t, OFF_H) WSF(cG, bf16_t, OFF_G) WSF(cMERGED, bf16_t, OFF_MERGED) WSF(cYCAT, bf16_t, OFF_YCAT)
WSF(cWINT, bf16_t, OFF_WIN_T) WSF(cGLUT, bf16_t, OFF_GLU_T) WSF(cBRT, bf16_t, OFF_BR_T) WSF(cOUTT, bf16_t, OFF_OUT_T) WSF(cUPT, bf16_t, OFF_UP_T) WSF(cDNT, bf16_t, OFF_DN_T)
WSF(cAY, bf16_t, OFF_AY) WSF(cEOUT, float, OFF_EOUT) WSF(cPE, bf16_t, OFF_PE) WSF(cPY, bf16_t, OFF_PY) WSF(cDST, float, OFF_DST) WSF(cQP, bf16_t, OFF_QP) WSF(cKR, bf16_t, OFF_KR)
WSF(cAO, bf16_t, OFF_AO) WSF(cKT2, bf16_t, OFF_KT2) WSF(cBO, bf16_t, OFF_BO) WSF(cZG, bf16_t, OFF_ZG) WSF(cZHYT, bf16_t, OFF_ZHYT) WSF(cZHYTC, bf16_t, OFF_ZHYTC) WSF(cOR, bf16_t, OFF_OR) WSF(cZGATE, bf16_t, OFF_ZGATE) WSF(cHID, bf16_t, OFF_HID) WSF(cYBUF, bf16_t, OFF_YBUF) WSF(cCNT, int, OFF_CTL)

template <int NBM, class ARow>
__device__ __forceinline__ void gemm_acc(float (&acc)[NBM][4][4], const ARow& arow, const float* B0, const float* B1, int ldb, int K, float* smem, int tid) {
    const int ty = tid >> 4, tx = tid & 15;
    float* As = smem;
    float* Bs0 = smem + 16 * 132;
    float* Bs1 = Bs0 + 16 * 64;
    const int arow_i = tid >> 2, akq = (tid & 3) * 4;
    const bf16_t* ap = arow(arow_i);
    const int bk = tid >> 5, bn = (tid & 31) * 2;
#pragma unroll 1
    for (int k0 = 0; k0 < K; k0 += 16) {
        ushort4 av = make_ushort4(0, 0, 0, 0);
        if (ap) av = *(const ushort4*)(ap + k0 + akq);
        const float2 bv0 = *(const float2*)(B0 + (size_t)(k0 + bk) * ldb + bn);
        float2 bv1 = make_float2(0.f, 0.f);
        if (NBM == 2) bv1 = *(const float2*)(B1 + (size_t)(k0 + bk) * ldb + bn);
        __syncthreads();
        As[(akq + 0) * 132 + arow_i] = bf2f(av.x); As[(akq + 1) * 132 + arow_i] = bf2f(av.y);
        As[(akq + 2) * 132 + arow_i] = bf2f(av.z); As[(akq + 3) * 132 + arow_i] = bf2f(av.w);
        Bs0[bk * 64 + bn] = bv0.x; Bs0[bk * 64 + bn + 1] = bv0.y;
        if (NBM == 2) { Bs1[bk * 64 + bn] = bv1.x; Bs1[bk * 64 + bn + 1] = bv1.y; }
        __syncthreads();
#pragma unroll 4
        for (int kk = 0; kk < 16; ++kk) {
            const float4 a4 = *(const float4*)&As[kk * 132 + ty * 4];
            const float4 b4 = *(const float4*)&Bs0[kk * 64 + tx * 4];
            const float a[4] = {a4.x, a4.y, a4.z, a4.w}; const float b[4] = {b4.x, b4.y, b4.z, b4.w};
#pragma unroll
            for (int i = 0; i < 4; ++i)
#pragma unroll
                for (int j = 0; j < 4; ++j) acc[0][i][j] += a[i] * b[j];
            if (NBM == 2) {
                const float4 c4 = *(const float4*)&Bs1[kk * 64 + tx * 4];
                const float c[4] = {c4.x, c4.y, c4.z, c4.w};
#pragma unroll
                for (int i = 0; i < 4; ++i)
#pragma unroll
                    for (int j = 0; j < 4; ++j) acc[1][i][j] += a[i] * c[j];
            }
        }
    }
    __syncthreads();
}
template <int NBM> __device__ __forceinline__ void zero_acc(float (&acc)[NBM][4][4]) {
#pragma unroll
    for (int b = 0; b < NBM; ++b)
#pragma unroll
        for (int i = 0; i < 4; ++i)
#pragma unroll
            for (int j = 0; j < 4; ++j) acc[b][i][j] = 0.f;
}
__device__ __forceinline__ void store_bf4(bf16_t* dst, float a, float b, float c, float d) {
    uint2 v; v.x = (unsigned)f2bf(a) | ((unsigned)f2bf(b) << 16); v.y = (unsigned)f2bf(c) | ((unsigned)f2bf(d) << 16); *(uint2*)dst = v;
}


namespace pg {
#define PG_LAS __attribute__((address_space(3)))
typedef short bf16x8 __attribute__((ext_vector_type(8)));
typedef float f32x4 __attribute__((ext_vector_type(4)));
typedef unsigned u32x4 __attribute__((ext_vector_type(4)));
typedef unsigned u32x2 __attribute__((ext_vector_type(2)));
constexpr int BM = 256, BK = 64, HALF = 128, HTB = HALF * BK * 2, STAGE_BYTES = 8 * HTB;
__device__ __forceinline__ int lds_byte(int r, int c) { const int st = (r >> 4) * 2 + (c >> 5), rr = r & 15, cc = c & 31, ob = rr * 64 + cc * 2; return st * 1024 + (ob ^ (((ob >> 9) & 1) << 5)); }
__device__ __forceinline__ void stage_rc(int b, int& R, int& C) { const int st = b / 1024, sb = b % 1024, swz = sb ^ (((sb >> 9) & 1) << 5); R = (st >> 1) * 16 + swz / 64; C = (st & 1) * 32 + (swz % 64) / 2; }
__device__ __forceinline__ int perm32(int rho) { const int n = rho >> 4, i = rho & 15; return 8 * (i >> 2) + 4 * n + (i & 3); }
__device__ __forceinline__ unsigned cvt_pk_bf16(float lo, float hi) { unsigned r; asm volatile("s_nop 1\n\tv_cvt_pk_bf16_f32 %0, %1, %2" : "=v"(r) : "v"(lo), "v"(hi)); return r; }

struct Unit { const char* a; const char* b; int pm, pn, aux, swap, K, ldb; };

template <class S> struct HalfB { static constexpr bool v = false; static __device__ __forceinline__ bool full(const Unit&) { return true; } };
template <bool SWAP, class Epi, class Sched>
__device__ __forceinline__ void gemm_phase(PG_LAS unsigned char* lds, const int K, const Sched& S, const Epi& E, const int tid) {
    const int wid = __builtin_amdgcn_readfirstlane(tid >> 6), lane = tid & 63, wr = wid >> 2, wc = wid & 3, fr = lane & 15, fq = lane >> 4;
    const int nt = K / BK;
    unsigned voffB[2];
#pragma unroll
    for (int i = 0; i < 2; ++i) { int sR, sC; stage_rc(tid * 16 + i * 8192, sR, sC); const int Rb = (sR & ~31) + perm32(sR & 31); voffB[i] = (unsigned)(Rb * S.ldb + sC) * 2u; }
#define PG_AOFF(u_, h_, i_) ([&]() { int sR, sC; stage_rc(tid * 16 + (i_) * 8192, sR, sC); return S.a_off(u_, h_, sR, sC); }())
    const size_t kstep = (size_t)(BK * 2);
    const size_t hstepB = (size_t)HALF * S.ldb * 2;
    const unsigned ldsw = (unsigned)wid * 1024u;
    const int aoff = lds_byte(wr * 64 + fr, fq * 8), boff = lds_byte(wc * 32 + fr, fq * 8);
#define PG_SA(b, h) (((b) * 2 + (h)) * HTB)
#define PG_SB(b, h) ((4 + (b) * 2 + (h)) * HTB)
#define PG_STAGE2(bufoff, gbase, o0, o1) do { \
        __builtin_amdgcn_global_load_lds((const unsigned*)((const char*)(gbase) + (o0)), (PG_LAS unsigned*)(lds + (bufoff) + ldsw), 16, 0, 0); \
        __builtin_amdgcn_global_load_lds((const unsigned*)((const char*)(gbase) + (o1)), (PG_LAS unsigned*)(lds + (bufoff) + ldsw + 8192), 16, 0, 0); } while (0)
#define PG_STAGEB(bufoff, gbase) PG_STAGE2(bufoff, gbase, voffB[0], voffB[1])
#define PG_LDA(dst, b, h) do { _Pragma("unroll") for (int m = 0; m < 4; ++m) _Pragma("unroll") for (int k = 0; k < 2; ++k) dst[m][k] = *(const PG_LAS bf16x8*)(lds + PG_SA(b, h) + aoff + m * 2048 + k * 1024); } while (0)
#define PG_LDB(dst, b, h) do { _Pragma("unroll") for (int n = 0; n < 2; ++n) _Pragma("unroll") for (int k = 0; k < 2; ++k) dst[n][k] = *(const PG_LAS bf16x8*)(lds + PG_SB(b, h) + boff + n * 2048 + k * 1024); } while (0)
#define PG_MMA(ai, bj, At, Bt) do { __builtin_amdgcn_s_setprio(1); \
        if constexpr (SWAP) { _Pragma("unroll") for (int m = 0; m < 4; ++m) _Pragma("unroll") for (int n = 0; n < 2; ++n) _Pragma("unroll") for (int k = 0; k < 2; ++k) \
            acc[ai][bj][m][n] = __builtin_amdgcn_mfma_f32_16x16x32_bf16(At[m][k], Bt[n][k], acc[ai][bj][m][n], 0, 0, 0); } \
        else { _Pragma("unroll") for (int m = 0; m < 4; ++m) _Pragma("unroll") for (int n = 0; n < 2; ++n) _Pragma("unroll") for (int k = 0; k < 2; ++k) \
            acc[ai][bj][m][n] = __builtin_amdgcn_mfma_f32_16x16x32_bf16(Bt[n][k], At[m][k], acc[ai][bj][m][n], 0, 0, 0); } \
        __builtin_amdgcn_s_setprio(0); } while (0)
#define PG_WAIT_V(n) asm volatile("s_waitcnt vmcnt(" #n ")" ::: "memory")
#define PG_WAIT_L(n) asm volatile("s_waitcnt lgkmcnt(" #n ")" ::: "memory")
#define PG_BAR __builtin_amdgcn_s_barrier()
#define PG_SCHED __builtin_amdgcn_sched_barrier(0)
    Unit cur, nxt; int ui = 0;
    if (!S.next(0, cur)) return;
    f32x4 acc[2][2][4][2];
#pragma unroll
    for (int a = 0; a < 2; ++a)
#pragma unroll
        for (int b = 0; b < 2; ++b)
#pragma unroll
            for (int m = 0; m < 4; ++m)
#pragma unroll
                for (int n = 0; n < 2; ++n) acc[a][b][m][n] = (f32x4){0.f, 0.f, 0.f, 0.f};
    bf16x8 At[4][2], B0[2][2], B1[2][2];
    unsigned c00 = PG_AOFF(cur, 0, 0), c01 = PG_AOFF(cur, 0, 1), c10 = PG_AOFF(cur, 1, 0), c11 = PG_AOFF(cur, 1, 1);
    const char* cA = cur.a; const char* cB = cur.b;
    PG_STAGEB(PG_SB(0, 0), cB); PG_STAGEB(PG_SB(0, 1), cB + hstepB); PG_STAGE2(PG_SA(0, 0), cA, c00, c01); PG_STAGE2(PG_SA(0, 1), cA, c10, c11);
    if (wr == 1) PG_BAR;
    PG_WAIT_V(2); PG_BAR;
    PG_STAGEB(PG_SB(1, 0), cB + kstep); PG_STAGE2(PG_SA(1, 0), cA + kstep, c00, c01); PG_STAGEB(PG_SB(1, 1), cB + hstepB + kstep);
    PG_WAIT_V(6); PG_BAR;
    for (;;) {
        const bool has_next = S.next(ui + 1, nxt);
        bool full = true; if constexpr (HalfB<Sched>::v) full = HalfB<Sched>::full(cur);
        const char* nA = has_next ? nxt.a : cA; const char* nB = has_next ? nxt.b : cB;
#pragma unroll 1
        for (int t = 0; t < nt; t += 2) {
            const bool last = (t == nt - 2);
            if constexpr (Epi::MID) { if (t == 8 || t == 16) { int fr_ = fr, fq_ = fq; asm volatile("" : "+v"(fr_), "+v"(fq_)); E.mid(acc, cur, t, wr, wc, fr_, fq_); } }
            const char* a1 = cA + (size_t)(t + 1) * kstep;
            const char* a2 = last ? nA : cA + (size_t)(t + 2) * kstep; const char* b2 = last ? nB : cB + (size_t)(t + 2) * kstep;
            const char* a3 = a2 + kstep; const char* b3 = b2 + kstep;
            PG_LDB(B0, 0, 0); PG_LDB(B1, 0, 1); PG_SCHED; PG_LDA(At, 0, 0); PG_STAGE2(PG_SA(1, 1), a1, c10, c11);
            if (last && has_next) { c00 = PG_AOFF(nxt, 0, 0); c01 = PG_AOFF(nxt, 0, 1); c10 = PG_AOFF(nxt, 1, 0); c11 = PG_AOFF(nxt, 1, 1); }
            PG_WAIT_V(8); PG_WAIT_L(0); PG_BAR; PG_MMA(0, 0, At, B0); if (full) PG_MMA(0, 1, At, B1); PG_BAR; PG_SCHED;
            PG_LDA(At, 0, 1); PG_STAGEB(PG_SB(0, 0), b2); PG_STAGEB(PG_SB(0, 1), b2 + hstepB); PG_STAGE2(PG_SA(0, 0), a2, c00, c01);
            PG_WAIT_V(8); PG_WAIT_L(0); PG_BAR; PG_MMA(1, 0, At, B0); if (full) PG_MMA(1, 1, At, B1); PG_BAR; PG_SCHED;
            PG_LDB(B0, 1, 0); PG_LDB(B1, 1, 1); PG_SCHED; PG_LDA(At, 1, 0); PG_STAGE2(PG_SA(0, 1), a2, c10, c11);
            PG_WAIT_V(8); PG_WAIT_L(0); PG_BAR; PG_MMA(0, 0, At, B0); if (full) PG_MMA(0, 1, At, B1); PG_BAR; PG_SCHED;
            PG_LDA(At, 1, 1); PG_STAGEB(PG_SB(1, 0), b3); PG_STAGEB(PG_SB(1, 1), b3 + hstepB); PG_STAGE2(PG_SA(1, 0), a3, c00, c01);
            PG_WAIT_V(8); PG_WAIT_L(0); PG_BAR; PG_MMA(1, 0, At, B0); if (full) PG_MMA(1, 1, At, B1); PG_BAR; PG_SCHED;
        }
        if (wr == 0) PG_BAR;
        { int fr_ = fr, fq_ = fq, wr_ = wr, wc_ = wc; asm volatile("" : "+v"(fr_), "+v"(fq_), "+s"(wr_), "+s"(wc_));
          E(acc, cur, wr_, wc_, fr_, fq_); }
        if (!has_next) break;
#pragma unroll
        for (int a = 0; a < 2; ++a)
#pragma unroll
            for (int b = 0; b < 2; ++b)
#pragma unroll
                for (int m = 0; m < 4; ++m)
#pragma unroll
                    for (int n = 0; n < 2; ++n) acc[a][b][m][n] = (f32x4){0.f, 0.f, 0.f, 0.f};
        cur = nxt; cA = nA; cB = nB; ++ui;
        if (wr == 1) PG_BAR;
    }
    PG_WAIT_V(0);
    PG_BAR;
#undef PG_AOFF
#undef PG_SA
#undef PG_SB
#undef PG_STAGE2
#undef PG_STAGEB
#undef PG_LDA
#undef PG_LDB
#undef PG_MMA
#undef PG_WAIT_V
#undef PG_WAIT_L
#undef PG_BAR
#undef PG_SCHED
}

template <class Epi, class Sched>
__device__ __forceinline__ void gemm_phase_var(PG_LAS unsigned char* lds, const Sched& S, const Epi& E, const int tid) {
    constexpr bool SWAP = false;
    const int wid = __builtin_amdgcn_readfirstlane(tid >> 6), wr = wid >> 2, wc = wid & 3;
#define PG_BOFF(ldb_, i_) ([&]() { int sR, sC; stage_rc(tid * 16 + (i_) * 8192, sR, sC); const int Rb = (sR & ~31) + perm32(sR & 31); return (unsigned)(Rb * (ldb_) + sC) * 2u; }())
#define PG_AOFF(u_, h_, i_) ([&]() { int sR, sC; stage_rc(tid * 16 + (i_) * 8192, sR, sC); return S.a_off(u_, h_, sR, sC); }())
    const size_t kstep = (size_t)(BK * 2);
    const unsigned ldsw = (unsigned)wid * 1024u;
    const int aoff = lds_byte(wr * 64 + (tid & 15), ((tid & 63) >> 4) * 8), boff = lds_byte(wc * 32 + (tid & 15), ((tid & 63) >> 4) * 8);
#define PG_SA(b, h) (((b) * 2 + (h)) * HTB)
#define PG_SB(b, h) ((4 + (b) * 2 + (h)) * HTB)
#define PG_STAGE2(bufoff, gbase, o0, o1) do { \
        __builtin_amdgcn_global_load_lds((const unsigned*)((const char*)(gbase) + (o0)), (PG_LAS unsigned*)(lds + (bufoff) + ldsw), 16, 0, 0); \
        __builtin_amdgcn_global_load_lds((const unsigned*)((const char*)(gbase) + (o1)), (PG_LAS unsigned*)(lds + (bufoff) + ldsw + 8192), 16, 0, 0); } while (0)
#define PG_STAGEB(bufoff, gbase) PG_STAGE2(bufoff, gbase, vB0, vB1)
#define PG_LDA(dst, b, h) do { _Pragma("unroll") for (int m = 0; m < 4; ++m) _Pragma("unroll") for (int k = 0; k < 2; ++k) dst[m][k] = *(const PG_LAS bf16x8*)(lds + PG_SA(b, h) + aoff + m * 2048 + k * 1024); } while (0)
#define PG_LDB(dst, b, h) do { _Pragma("unroll") for (int n = 0; n < 2; ++n) _Pragma("unroll") for (int k = 0; k < 2; ++k) dst[n][k] = *(const PG_LAS bf16x8*)(lds + PG_SB(b, h) + boff + n * 2048 + k * 1024); } while (0)
#define PG_MMA(ai, bj, At, Bt) do { __builtin_amdgcn_s_setprio(1); \
        if constexpr (SWAP) { _Pragma("unroll") for (int m = 0; m < 4; ++m) _Pragma("unroll") for (int n = 0; n < 2; ++n) _Pragma("unroll") for (int k = 0; k < 2; ++k) \
            acc[ai][bj][m][n] = __builtin_amdgcn_mfma_f32_16x16x32_bf16(At[m][k], Bt[n][k], acc[ai][bj][m][n], 0, 0, 0); } \
        else { _Pragma("unroll") for (int m = 0; m < 4; ++m) _Pragma("unroll") for (int n = 0; n < 2; ++n) _Pragma("unroll") for (int k = 0; k < 2; ++k) \
            acc[ai][bj][m][n] = __builtin_amdgcn_mfma_f32_16x16x32_bf16(Bt[n][k], At[m][k], acc[ai][bj][m][n], 0, 0, 0); } \
        __builtin_amdgcn_s_setprio(0); } while (0)
#define PG_WAIT_V(n) asm volatile("s_waitcnt vmcnt(" #n ")" ::: "memory")
#define PG_WAIT_L(n) asm volatile("s_waitcnt lgkmcnt(" #n ")" ::: "memory")
#define PG_BAR __builtin_amdgcn_s_barrier()
#define PG_SCHED __builtin_amdgcn_sched_barrier(0)
    Unit cur, nxt; int ui = 0;
    if (!S.next(0, cur)) return;
    int nt = cur.K / BK; unsigned vB0 = PG_BOFF(cur.ldb, 0), vB1 = PG_BOFF(cur.ldb, 1); size_t hstepB = (size_t)HALF * cur.ldb * 2;
    f32x4 acc[2][2][4][2];
#pragma unroll
    for (int a = 0; a < 2; ++a)
#pragma unroll
        for (int b = 0; b < 2; ++b)
#pragma unroll
            for (int m = 0; m < 4; ++m)
#pragma unroll
                for (int n = 0; n < 2; ++n) acc[a][b][m][n] = (f32x4){0.f, 0.f, 0.f, 0.f};
    bf16x8 At[4][2], B0[2][2], B1[2][2];
    unsigned c00 = PG_AOFF(cur, 0, 0), c01 = PG_AOFF(cur, 0, 1), c10 = PG_AOFF(cur, 1, 0), c11 = PG_AOFF(cur, 1, 1);
    const char* cA = cur.a; const char* cB = cur.b;
    PG_STAGEB(PG_SB(0, 0), cB); PG_STAGEB(PG_SB(0, 1), cB + hstepB); PG_STAGE2(PG_SA(0, 0), cA, c00, c01); PG_STAGE2(PG_SA(0, 1), cA, c10, c11);
    if (wr == 1) PG_BAR;
    PG_WAIT_V(2); PG_BAR;
    PG_STAGEB(PG_SB(1, 0), cB + kstep); PG_STAGE2(PG_SA(1, 0), cA + kstep, c00, c01); PG_STAGEB(PG_SB(1, 1), cB + hstepB + kstep);
    PG_WAIT_V(6); PG_BAR;
    for (;;) {
        const bool has_next = S.next(ui + 1, nxt);
        const bool dep = has_next && S.defer(nxt);
        bool pre = has_next && !dep;
        const char* nA = pre ? nxt.a : cA; const char* nB = pre ? nxt.b : cB;
#pragma unroll 1
        for (int t = 0; t < nt; t += 2) {
            const bool last = (t == nt - 2);
            if constexpr (Epi::MID) { if ((t == 8 || t == 16) && E.has_mid(cur)) { int fr_ = tid & 15, fq_ = (tid & 63) >> 4; asm volatile("" : "+v"(fr_), "+v"(fq_)); E.mid(acc, cur, t, wr, wc, fr_, fq_); } }
            if (last && dep) {
                volatile PG_LAS int* flag = (volatile PG_LAS int*)(lds + 8 * HTB + 4096);
                if (tid < 64) { const bool ok = S.try_ready(nxt); if (tid == 0) *flag = ok ? 1 : 0; PG_WAIT_L(0); }
                asm volatile("" ::: "memory"); PG_BAR; asm volatile("" ::: "memory");
                pre = __builtin_amdgcn_readfirstlane(*flag) != 0;
                if (pre) { nA = nxt.a; nB = nxt.b; }
            }
            const char* a1 = cA + (size_t)(t + 1) * kstep;
            const char* a2 = last ? nA : cA + (size_t)(t + 2) * kstep; const char* b2 = last ? nB : cB + (size_t)(t + 2) * kstep;
            const char* a3 = a2 + kstep; const char* b3 = b2 + kstep;
            PG_LDB(B0, 0, 0); PG_LDB(B1, 0, 1); PG_SCHED; PG_LDA(At, 0, 0); PG_STAGE2(PG_SA(1, 1), a1, c10, c11);
            if (last && pre) { c00 = PG_AOFF(nxt, 0, 0); c01 = PG_AOFF(nxt, 0, 1);
                                    vB0 = PG_BOFF(nxt.ldb, 0); vB1 = PG_BOFF(nxt.ldb, 1); hstepB = (size_t)HALF * nxt.ldb * 2; }
            PG_WAIT_V(8); PG_WAIT_L(0); PG_BAR; PG_MMA(0, 0, At, B0); PG_MMA(0, 1, At, B1); PG_BAR; PG_SCHED;
            PG_LDA(At, 0, 1); PG_STAGEB(PG_SB(0, 0), b2); PG_STAGEB(PG_SB(0, 1), b2 + hstepB); PG_STAGE2(PG_SA(0, 0), a2, c00, c01);
            if (last && pre) { c10 = PG_AOFF(nxt, 1, 0); c11 = PG_AOFF(nxt, 1, 1); }
            PG_WAIT_V(8); PG_WAIT_L(0); PG_BAR; PG_MMA(1, 0, At, B0); PG_MMA(1, 1, At, B1); PG_BAR; PG_SCHED;
            PG_LDB(B0, 1, 0); PG_LDB(B1, 1, 1); PG_SCHED; PG_LDA(At, 1, 0); PG_STAGE2(PG_SA(0, 1), a2, c10, c11);
            PG_WAIT_V(8); PG_WAIT_L(0); PG_BAR; PG_MMA(0, 0, At, B0); PG_MMA(0, 1, At, B1); PG_BAR; PG_SCHED;
            PG_LDA(At, 1, 1); PG_STAGEB(PG_SB(1, 0), b3); PG_STAGEB(PG_SB(1, 1), b3 + hstepB); PG_STAGE2(PG_SA(1, 0), a3, c00, c01);
            PG_WAIT_V(8); PG_WAIT_L(0); PG_BAR; PG_MMA(1, 0, At, B0); PG_MMA(1, 1, At, B1); PG_BAR; PG_SCHED;
        }
        if (wr == 0) PG_BAR;
        { int fr_ = tid & 15, fq_ = (tid & 63) >> 4, wr_ = wr, wc_ = wc; asm volatile("" : "+v"(fr_), "+v"(fq_), "+s"(wr_), "+s"(wc_));
          E(acc, cur, wr_, wc_, fr_, fq_); }
        S.publish(cur, tid);
        if (!has_next) break;
#pragma unroll
        for (int a = 0; a < 2; ++a)
#pragma unroll
            for (int b = 0; b < 2; ++b)
#pragma unroll
                for (int m = 0; m < 4; ++m)
#pragma unroll
                    for (int n = 0; n < 2; ++n) acc[a][b][m][n] = (f32x4){0.f, 0.f, 0.f, 0.f};
        cur = nxt; cA = cur.a; cB = cur.b; ++ui; nt = cur.K / BK;
        if (pre) { if (wr == 1) PG_BAR; }
        else {
            PG_WAIT_V(0);
            S.wait_ready(cur, tid);
            c00 = PG_AOFF(cur, 0, 0); c01 = PG_AOFF(cur, 0, 1); c10 = PG_AOFF(cur, 1, 0); c11 = PG_AOFF(cur, 1, 1);
            vB0 = PG_BOFF(cur.ldb, 0); vB1 = PG_BOFF(cur.ldb, 1); hstepB = (size_t)HALF * cur.ldb * 2;
            PG_STAGEB(PG_SB(0, 0), cB); PG_STAGEB(PG_SB(0, 1), cB + hstepB); PG_STAGE2(PG_SA(0, 0), cA, c00, c01); PG_STAGE2(PG_SA(0, 1), cA, c10, c11);
            if (wr == 1) PG_BAR;
            PG_WAIT_V(2); PG_BAR;
            PG_STAGEB(PG_SB(1, 0), cB + kstep); PG_STAGE2(PG_SA(1, 0), cA + kstep, c00, c01); PG_STAGEB(PG_SB(1, 1), cB + hstepB + kstep);
            PG_WAIT_V(6); PG_BAR;
        }
    }
    PG_WAIT_V(0);
    PG_BAR;
#undef PG_AOFF
#undef PG_BOFF
#undef PG_SA
#undef PG_SB
#undef PG_STAGE2
#undef PG_STAGEB
#undef PG_LDA
#undef PG_LDB
#undef PG_MMA
#undef PG_WAIT_V
#undef PG_WAIT_L
#undef PG_BAR
#undef PG_SCHED
}

__device__ __forceinline__ void static_tile(int L, int nM, int nN, int& pm, int& pn) {
    const int nwg = nM * nN, NX = 8, WGM = 8;
    int wgid = L; { const int q = nwg / NX, r = nwg % NX, xcd = wgid % NX, off = wgid / NX; wgid = (xcd < r ? xcd * (q + 1) : r * (q + 1) + (xcd - r) * q) + off; }
    const int nig = WGM * nN, gid = wgid / nig, fm = gid * WGM, gsz = (nM - fm) < WGM ? (nM - fm) : WGM;
    pm = fm + ((wgid % nig) % gsz); pn = (wgid % nig) / gsz;
}
}

__device__ __forceinline__ pg::u32x4 pack8(const pg::f32x4& v0, const pg::f32x4& v1) {
    pg::u32x4 w; w.x = pg::cvt_pk_bf16(v0[0], v0[1]); w.y = pg::cvt_pk_bf16(v0[2], v0[3]); w.z = pg::cvt_pk_bf16(v1[0], v1[1]); w.w = pg::cvt_pk_bf16(v1[2], v1[3]); return w;
}
__device__ __forceinline__ void unpack8(const pg::u32x4& w, float (&f)[8]) {
    f[0] = __uint_as_float(w.x << 16); f[1] = __uint_as_float(w.x & 0xffff0000u); f[2] = __uint_as_float(w.y << 16); f[3] = __uint_as_float(w.y & 0xffff0000u);
    f[4] = __uint_as_float(w.z << 16); f[5] = __uint_as_float(w.z & 0xffff0000u); f[6] = __uint_as_float(w.w << 16); f[7] = __uint_as_float(w.w & 0xffff0000u);
}

struct ConvTile { const float* src; bf16_t* dst; int N, ldd, mode; };
__device__ __forceinline__ void conv_load(const ConvTile& t, float4 (&v)[8], int tid) {
    const int kk = tid >> 4, n4 = (tid & 15) * 4;
#pragma unroll
    for (int i = 0; i < 8; ++i) v[i] = *(const float4*)(t.src + (size_t)(kk * 8 + i) * t.N + n4);
}
__device__ __forceinline__ void conv_store(const ConvTile& t, const float4 (&v)[8], float* sm, int tid) {
    bf16_t* tile = (bf16_t*)sm;
    const int kk = tid >> 4, n4 = (tid & 15) * 4;
    __syncthreads();
    {
        const int pos = (kk ^ ((n4 >> 2) & 7)) * 8;
        uint4 w;
        w.x = (unsigned)f2bf(v[0].x) | ((unsigned)f2bf(v[1].x) << 16); w.y = (unsigned)f2bf(v[2].x) | ((unsigned)f2bf(v[3].x) << 16); w.z = (unsigned)f2bf(v[4].x) | ((unsigned)f2bf(v[5].x) << 16); w.w = (unsigned)f2bf(v[6].x) | ((unsigned)f2bf(v[7].x) << 16);
        *(uint4*)(tile + (n4 + 0) * 264 + pos) = w;
        w.x = (unsigned)f2bf(v[0].y) | ((unsigned)f2bf(v[1].y) << 16); w.y = (unsigned)f2bf(v[2].y) | ((unsigned)f2bf(v[3].y) << 16); w.z = (unsigned)f2bf(v[4].y) | ((unsigned)f2bf(v[5].y) << 16); w.w = (unsigned)f2bf(v[6].y) | ((unsigned)f2bf(v[7].y) << 16);
        *(uint4*)(tile + (n4 + 1) * 264 + pos) = w;
        w.x = (unsigned)f2bf(v[0].z) | ((unsigned)f2bf(v[1].z) << 16); w.y = (unsigned)f2bf(v[2].z) | ((unsigned)f2bf(v[3].z) << 16); w.z = (unsigned)f2bf(v[4].z) | ((unsigned)f2bf(v[5].z) << 16); w.w = (unsigned)f2bf(v[6].z) | ((unsigned)f2bf(v[7].z) << 16);
        *(uint4*)(tile + (n4 + 2) * 264 + pos) = w;
        w.x = (unsigned)f2bf(v[0].w) | ((unsigned)f2bf(v[1].w) << 16); w.y = (unsigned)f2bf(v[2].w) | ((unsigned)f2bf(v[3].w) << 16); w.z = (unsigned)f2bf(v[4].w) | ((unsigned)f2bf(v[5].w) << 16); w.w = (unsigned)f2bf(v[6].w) | ((unsigned)f2bf(v[7].w) << 16);
        *(uint4*)(tile + (n4 + 3) * 264 + pos) = w;
    }
    __syncthreads();
#pragma unroll
    for (int i = 0; i < 4; ++i) {
        const int e = tid + i * NT, nn = e >> 5, kc = e & 31;
        const int row = t.mode == 0 ? nn : ((t.mode == 2 ? 128 : 0) + nn);
        *(uint4*)(t.dst + (size_t)row * t.ldd + kc * 8) = *(const uint4*)(tile + nn * 264 + (kc ^ ((nn >> 2) & 7)) * 8);
    }
}

__device__ __forceinline__ float posemb(int pos, int dd) {
    const int i = dd & 255;
    const float omega = 1.0f / powf(10000.0f, (float)i / 256.0f);
    const float ang = (float)pos * omega;
    return dd < 256 ? sinf(ang) : cosf(ang);
}
struct HyFiltW { float w1[33]; float w2[64]; float b1, b2, f0, f1; };
__device__ __forceinline__ void hy_filter_load(const Ctx& c, int l, HyFiltW& W) {
    const float* w1 = c.p->in[I_HYW1] + (size_t)l * 33 * 64; const float* w2 = c.p->in[I_HYW2] + (size_t)l * 64 * 64;
#pragma unroll
    for (int i = 0; i < 33; ++i) W.w1[i] = w1[i * 64 + c.lane];
#pragma unroll
    for (int i = 0; i < 64; ++i) W.w2[i] = w2[i * 64 + c.lane];
    W.b1 = c.p->in[I_HYB1][l * 64 + c.lane]; W.b2 = c.p->in[I_HYB2][l * 64 + c.lane];
    W.f0 = c.p->in[I_HYFREQ][(l * 2 + 0) * 64 + c.lane]; W.f1 = c.p->in[I_HYFREQ][(l * 2 + 1) * 64 + c.lane];
}
__device__ __forceinline__ void hy_filter_item(const Ctx& c, const HyFiltW& W, int ntok, int t, bf16_t* dst, int dstride, int doff, const float* w3s) {
    const int lane = c.lane;
    const float tt = (float)t / (float)(ntok - 1);
    const float w = 6.283185307179586f * (float)t / (float)ntok;
    float a = W.b1 + tt * W.w1[0];
#pragma unroll
    for (int j = 0; j < 16; ++j) {
        const float f = 1e-4f + (float)j * ((15.0f - 1e-4f) / 15.0f);
        const float ang = f * w;
        a += __cosf(ang) * W.w1[1 + j];
        a += -__sinf(ang) * W.w1[17 + j];
    }
    const float h1 = __sinf(W.f0 * a);
    float a2 = W.b2;
#pragma unroll
    for (int i = 0; i < 64; ++i) a2 += __int_as_float(__builtin_amdgcn_readlane(__float_as_int(h1), i)) * W.w2[i];
    const float h2 = __sinf(W.f1 * a2);
    float acc[8];
#pragma unroll
    for (int m = 0; m < 8; ++m) acc[m] = 0.f;
#pragma unroll 4
    for (int j = 0; j < 64; ++j) {
        const float hj = __int_as_float(__builtin_amdgcn_readlane(__float_as_int(h2), j));
#pragma unroll
        for (int m = 0; m < 8; ++m) acc[m] += hj * w3s[j * 512 + m * 64 + lane];
    }
    const float offset = fabsf((float)(t - ntok / 2)) / (float)ntok;
    const float lo = logf(1e-2f) / 1.5f, hi = logf(1e-2f) / 0.3f;
#pragma unroll
    for (int m = 0; m < 8; ++m) {
        const int ch = m * 64 + lane;
        const float delta = fabsf(lo + (float)ch * ((hi - lo) / 511.0f));
        dst[(size_t)ch * dstride + doff] = f2bf(acc[m] * expf(-offset * delta));
    }
}
__device__ __forceinline__ void s5_param_item(const Ctx& c, int l, int g);
__device__ __forceinline__ void phase_init(const Ctx& c) {
    const int gtid = c.bid * NT + c.tid, gthreads = c.nblk * NT;
    for (int idx = gtid; idx < 64 * 512; idx += gthreads) cPET(c)[idx] = posemb(idx >> 9, idx & 511);
    {
        float* s = c.smem;
        float* red = c.smem + 5 * 1024;
        __syncthreads();
        for (int i = c.tid; i < 5 * 1024; i += NT) { const float v = (i < 4096) ? c.p->in[I_C][i] : c.p->in[I_CCTX][i - 4096]; s[i] = siluf_(v); }
        __syncthreads();
#pragma unroll 1
        for (int it = c.bid; it < 256; it += c.nblk) {
            const int l = it >> 7, n0 = (it & 127) * 48;
            const int c4 = c.tid % 12, kg = c.tid / 12;
            if (kg < 40) {
                float acc[5][4];
#pragma unroll
                for (int i = 0; i < 5; ++i)
#pragma unroll
                    for (int j = 0; j < 4; ++j) acc[i][j] = 0.f;
                const float* wm = c.p->in[I_WMOD] + (size_t)l * 1024 * 6144 + n0 + c4 * 4;
#pragma unroll 1
                for (int hb = 0; hb < 2; ++hb) {
                    float4 w[13];
#pragma unroll
                    for (int q = 0; q < 13; ++q) { const int k = kg + 40 * (hb * 13 + q); w[q] = k < 1024 ? *(const float4*)(wm + (size_t)k * 6144) : make_float4(0.f, 0.f, 0.f, 0.f); }
#pragma unroll
                    for (int q = 0; q < 13; ++q) {
                        const int k = kg + 40 * (hb * 13 + q);
                        if (k < 1024) {
#pragma unroll
                            for (int i = 0; i < 5; ++i) { const float sv = s[i * 1024 + k]; acc[i][0] += sv * w[q].x; acc[i][1] += sv * w[q].y; acc[i][2] += sv * w[q].z; acc[i][3] += sv * w[q].w; }
                        }
                    }
                }
#pragma unroll
                for (int i = 0; i < 5; ++i)
#pragma unroll
                    for (int j = 0; j < 4; ++j) red[(kg * 48 + c4 * 4 + j) * 5 + i] = acc[i][j];
            }
            __syncthreads();
            if (c.tid < 240) {
                const int cl = c.tid / 5, i = c.tid % 5;
                float t = c.p->in[I_BMOD][l * 6144 + n0 + cl];
#pragma unroll 8
                for (int q = 0; q < 40; ++q) t += red[(q * 48 + cl) * 5 + i];
                cMOD(c)[(l * 5 + i) * 6144 + n0 + cl] = t;
            }
            __syncthreads();
        }
    }
    if (c.bid >= 64) {
        float* w3s = c.smem;
        bf16_t* stg = (bf16_t*)(c.smem + 64 * 512);
        const int rank = c.bid - 64, nrank = c.nblk - 64;
#pragma unroll 1
        for (int l = 0; l < 2; ++l) {
            HyFiltW W; hy_filter_load(c, l, W);
            __syncthreads();
            { const float* w3 = c.p->in[I_HYW3] + (size_t)l * 64 * 512; for (int i = c.tid; i < 64 * 512 / 4; i += NT) ((float4*)w3s)[i] = ((const float4*)w3)[i]; }
            __syncthreads();
            const int nit = (l == 0) ? (L + LC) / 8 : L / 8;
#pragma unroll 1
            for (int it = rank; it < nit; it += nrank) {
                int ntok, t0; bf16_t* dst;
                if (it < L / 8) { t0 = it * 8; ntok = L; dst = cFILT(c) + (size_t)l * 512 * L; }
                else { t0 = (it - L / 8) * 8; ntok = LC; dst = cFILTC(c); }
                hy_filter_item(c, W, ntok, t0 + c.wave, stg + c.wave, 8, 0, w3s);
                __syncthreads();
                *(uint4*)(dst + (size_t)c.tid * ntok + t0) = *(const uint4*)(stg + c.tid * 8);
                __syncthreads();
            }
        }
    }
#pragma unroll 1
    for (int it = c.bid; it < 64; it += c.nblk) s5_param_item(c, it >> 5, it & 31);
}

__device__ __forceinline__ void norm_apply(const Ctx& c, int l, int r, int which, float (&y)[16]) {
    const float* mod = cMOD(c) + (size_t)(l * 5 + (r < RL ? r / L : 4)) * 6144 + (which ? 3072 : 0);
    const float* g = c.p->in[which ? I_N2G : I_N1G] + l * D;
    float ss = 0.f;
#pragma unroll
    for (int i = 0; i < 16; ++i) ss += y[i] * y[i];
    ss = wave_sum(ss, c.lane);
    const float rinv = rsqrtf(ss * (1.0f / 1024.0f) + 1e-6f);
#pragma unroll
    for (int j = 0; j < 4; ++j) {
        const int d = (j * 64 + c.lane) * 4;
        const float4 gg = *(const float4*)(g + d), sh = *(const float4*)(mod + d), sc = *(const float4*)(mod + 1024 + d);
        y[j * 4 + 0] = y[j * 4 + 0] * rinv * gg.x * (1.f + sc.x) + sh.x;
        y[j * 4 + 1] = y[j * 4 + 1] * rinv * gg.y * (1.f + sc.y) + sh.y;
        y[j * 4 + 2] = y[j * 4 + 2] * rinv * gg.z * (1.f + sc.z) + sh.z;
        y[j * 4 + 3] = y[j * 4 + 3] * rinv * gg.w * (1.f + sc.w) + sh.w;
    }
}
__device__ __forceinline__ void norm_row(const Ctx& c, int l, int r, int which, float (&y)[16]) {
    const float* src = r < RL ? c.X + (size_t)r * D : cXC(c) + (size_t)(r - RL) * D;
#pragma unroll
    for (int j = 0; j < 4; ++j) {
        const float4 v = *(const float4*)(src + (j * 64 + c.lane) * 4);
        y[j * 4 + 0] = v.x; y[j * 4 + 1] = v.y; y[j * 4 + 2] = v.z; y[j * 4 + 3] = v.w;
    }
    norm_apply(c, l, r, which, y);
}
__device__ __forceinline__ ConvTile conv_desc(const Ctx& c, int l, int it) {
    ConvTile t; int r = it;
    if (r < 448) { const int k0 = (r / 112) * 256, n0 = (r % 112) * 64; t.N = INC; t.ldd = 1024; t.mode = 0; t.src = c.p->in[I_WIN] + (size_t)l * D * INC + (size_t)k0 * INC + n0; t.dst = cWINT(c) + (size_t)n0 * 1024 + k0; return t; }
    r -= 448;
    if (r < 32) { const int w = r >> 4, q = r & 15, k0 = (q >> 3) * 256, n0 = (q & 7) * 64; t.N = 512; t.ldd = 512; t.mode = 1 + w;
        t.src = c.p->in[w ? I_GLU2 : I_GLU1] + (size_t)l * 512 * 512 + (size_t)k0 * 512 + n0; t.dst = cGLUT(c) + (size_t)((n0 >> 7) * 256 + (n0 & 127)) * 512 + k0; return t; }
    r -= 32;
    if (r < 96) { const int nb = r >> 5, q = r & 31, k0 = (q >> 4) * 256, n0 = (q & 15) * 64; t.N = 1024; t.ldd = 1536; t.mode = 0;
        t.src = c.p->in[I_WBR] + (size_t)(l * 3 + nb) * 512 * 1024 + (size_t)k0 * 1024 + n0; t.dst = cBRT(c) + (size_t)n0 * 1536 + nb * 512 + k0; return t; }
    r -= 96;
    if (r < 64) { const int k0 = (r >> 4) * 256, n0 = (r & 15) * 64; t.N = 1024; t.ldd = 1024; t.mode = 0; t.src = c.p->in[I_WOUT] + (size_t)l * 1024 * 1024 + (size_t)k0 * 1024 + n0; t.dst = cOUTT(c) + (size_t)n0 * 1024 + k0; return t; }
    r -= 64;
    if (r < 2048) { const int w = r >> 10, e = (r >> 5) & 31, q = r & 31, k0 = (q >> 3) * 256, n0 = (q & 7) * 64; t.N = 512; t.ldd = 1024; t.mode = 1 + w;
        t.src = c.p->in[w ? I_MW3 : I_MW1] + (size_t)(l * 32 + e) * 1024 * 512 + (size_t)k0 * 512 + n0; t.dst = cUPT(c) + (size_t)e * 1024 * 1024 + (size_t)((n0 >> 7) * 256 + (n0 & 127)) * 1024 + k0; return t; }
    r -= 2048;
    { const int e = r >> 5, q = r & 31, k0 = (q >> 4) * 256, n0 = (q & 15) * 64; t.N = 1024; t.ldd = 512; t.mode = 0;
      t.src = c.p->in[I_MW2] + (size_t)(l * 32 + e) * 512 * 1024 + (size_t)k0 * 1024 + n0; t.dst = cDNT(c) + (size_t)e * 1024 * 512 + (size_t)n0 * 512 + k0; return t; }
}
__device__ __forceinline__ void phase_convert(const Ctx& c, int l, const bool moe, int rank = -1, int nrank = 0) {
    if (rank < 0) { rank = c.bid; nrank = c.nblk; }
    const int first = rank + (moe ? 640 : 0), end = moe ? 3712 : 640;
    if (first >= end) return;
    float4 v[8];
    ConvTile cur = conv_desc(c, l, first);
    conv_load(cur, v, c.tid);
#pragma unroll 1
    for (int it = first; it < end; it += nrank) {
        float4 w[8];
        const int nx = it + nrank;
        ConvTile nxt = cur;
        if (nx < end) { nxt = conv_desc(c, l, nx); conv_load(nxt, w, c.tid); }
        conv_store(cur, v, c.smem, c.tid);
        cur = nxt;
#pragma unroll
        for (int i = 0; i < 8; ++i) v[i] = w[i];
    }
}
__device__ __forceinline__ void phase_norm1(const Ctx& c, int l) {
    phase_convert(c, l, false);
    const int gw = c.bid * 8 + c.wave, nw = c.nblk * 8;
    for (int r = gw; r < R; r += nw) {
        float y[16];
        if (r < RL) {
            const int t = r & (L - 1);
            const float* xs = c.p->in[I_X] + (size_t)r * D;
            const float* per = cPET(c) + (t >> 6) * 512; const float* pec = cPET(c) + (t & 63) * 512;
#pragma unroll
            for (int j = 0; j < 4; ++j) {
                const int d = (j * 64 + c.lane) * 4;
                const float4 xv = *(const float4*)(xs + d);
                const float4 pv = d < 512 ? *(const float4*)(per + d) : *(const float4*)(pec + d - 512);
                y[j * 4] = xv.x + pv.x; y[j * 4 + 1] = xv.y + pv.y; y[j * 4 + 2] = xv.z + pv.z; y[j * 4 + 3] = xv.w + pv.w;
                *(float4*)(c.X + (size_t)r * D + d) = make_float4(y[j * 4], y[j * 4 + 1], y[j * 4 + 2], y[j * 4 + 3]);
            }
        } else {
            const float* xs = c.p->in[I_CTX] + (size_t)(r - RL) * D;
#pragma unroll
            for (int j = 0; j < 4; ++j) {
                const int d = (j * 64 + c.lane) * 4;
                const float4 xv = *(const float4*)(xs + d);
                y[j * 4] = xv.x; y[j * 4 + 1] = xv.y; y[j * 4 + 2] = xv.z; y[j * 4 + 3] = xv.w;
                *(float4*)(cXC(c) + (size_t)(r - RL) * D + d) = xv;
            }
        }
        norm_apply(c, l, r, 0, y);
#pragma unroll
        for (int j = 0; j < 4; ++j) store_bf4(cH(c) + (size_t)r * D + (j * 64 + c.lane) * 4, y[j * 4], y[j * 4 + 1], y[j * 4 + 2], y[j * 4 + 3]);
    }
}
__device__ __forceinline__ void phase_norm2_route(const Ctx& c, int l) {
    PG_LAS unsigned char* lds = (PG_LAS unsigned char*)c.smem;
    constexpr int HP = 1032 * 2;
    constexpr int O_LO = 16 * HP, O_PART = 2 * 16 * HP, O_LG = O_PART + 8 * 3 * 64 * 16;
    const int nrows = (l == 0) ? R : RL;
    const float* wg = c.p->in[I_MWG] + (size_t)l * D * 4; const float* we = c.p->in[I_MWE] + (size_t)l * D * 32;
    int* lcnt = (int*)((unsigned char*)c.smem + LDS_SH);
    const int tid = c.tid, lane = c.lane, wave = c.wave;
    __syncthreads();
    if (tid < 64) lcnt[tid] = 0;
    pg::bf16x8 breg[3][4];
#pragma unroll
    for (int ct = 0; ct < 3; ++ct)
#pragma unroll
        for (int ks = 0; ks < 4; ++ks) {
            const int col = ct * 16 + (lane & 15), k0 = wave * 128 + ks * 32 + (lane >> 4) * 8;
            unsigned w[4];
#pragma unroll
            for (int j = 0; j < 4; ++j) {
                float a = 0.f, b = 0.f;
                if (col < 4) { a = wg[(k0 + 2 * j) * 4 + col]; b = wg[(k0 + 2 * j + 1) * 4 + col]; }
                else if (col < 36) { a = we[(k0 + 2 * j) * 32 + col - 4]; b = we[(k0 + 2 * j + 1) * 32 + col - 4]; }
                w[j] = (unsigned)f2bf(a) | ((unsigned)f2bf(b) << 16);
            }
            breg[ct][ks] = __builtin_bit_cast(pg::bf16x8, (pg::u32x4){w[0], w[1], w[2], w[3]});
        }
    const int rpb = (nrows + c.nblk - 1) / c.nblk, row0 = c.bid * rpb;
    const int cnt = nrows - row0 < rpb ? (nrows - row0 > 0 ? nrows - row0 : 0) : rpb;
    __syncthreads();
#pragma unroll 1
    for (int sb = 0; sb * 16 < cnt; ++sb) {
        const int nsb = cnt - sb * 16 < 16 ? cnt - sb * 16 : 16;
#pragma unroll 1
        for (int q = 0; q < 2; ++q) {
            const int rl = wave * 2 + q;
            if (rl < nsb) {
                const int r = row0 + sb * 16 + rl;
                float y[16];
                norm_row(c, l, r, 1, y);
#pragma unroll
                for (int j = 0; j < 4; ++j) {
                    const int d = (j * 64 + lane) * 4;
                    const unsigned h0 = pg::cvt_pk_bf16(y[j * 4], y[j * 4 + 1]), h1 = pg::cvt_pk_bf16(y[j * 4 + 2], y[j * 4 + 3]);
                    *(uint2*)(cH(c) + (size_t)r * D + d) = make_uint2(h0, h1);
                    const unsigned l0 = pg::cvt_pk_bf16(y[j * 4] - __uint_as_float(h0 << 16), y[j * 4 + 1] - __uint_as_float(h0 & 0xffff0000u));
                    const unsigned l1 = pg::cvt_pk_bf16(y[j * 4 + 2] - __uint_as_float(h1 << 16), y[j * 4 + 3] - __uint_as_float(h1 & 0xffff0000u));
                    *(PG_LAS pg::u32x2*)(lds + rl * HP + d * 2) = (pg::u32x2){h0, h1};
                    *(PG_LAS pg::u32x2*)(lds + O_LO + rl * HP + d * 2) = (pg::u32x2){l0, l1};
                }
            }
        }
        __syncthreads();
        {
            pg::f32x4 acc[3];
#pragma unroll
            for (int ct = 0; ct < 3; ++ct) acc[ct] = (pg::f32x4){0.f, 0.f, 0.f, 0.f};
#pragma unroll
            for (int ks = 0; ks < 4; ++ks) {
                const int off = (lane & 15) * HP + (wave * 128 + ks * 32 + (lane >> 4) * 8) * 2;
                const pg::bf16x8 ah = *(const PG_LAS pg::bf16x8*)(lds + off), al = *(const PG_LAS pg::bf16x8*)(lds + O_LO + off);
#pragma unroll
                for (int ct = 0; ct < 3; ++ct) {
                    acc[ct] = __builtin_amdgcn_mfma_f32_16x16x32_bf16(ah, breg[ct][ks], acc[ct], 0, 0, 0);
                    acc[ct] = __builtin_amdgcn_mfma_f32_16x16x32_bf16(al, breg[ct][ks], acc[ct], 0, 0, 0);
                }
            }
#pragma unroll
            for (int ct = 0; ct < 3; ++ct) *(PG_LAS pg::f32x4*)(lds + O_PART + ((wave * 3 + ct) * 64 + lane) * 16) = acc[ct];
        }
        __syncthreads();
        if (tid < 256) {
            const int row = tid >> 4, c3 = tid & 15, sl = (row >> 2) * 16 + c3, rg = row & 3;
#pragma unroll
            for (int ct = 0; ct < 3; ++ct) {
                float s = 0.f;
#pragma unroll
                for (int w = 0; w < 8; ++w) s += *(const PG_LAS float*)(lds + O_PART + ((w * 3 + ct) * 64 + sl) * 16 + rg * 4);
                *(PG_LAS float*)(lds + O_LG + (row * 48 + ct * 16 + c3) * 4) = s;
            }
        }
        __syncthreads();
        if (tid < nsb) {
            const int r = row0 + sb * 16 + tid;
            const PG_LAS float* lg = (const PG_LAS float*)(lds + O_LG + tid * 48 * 4);
            float gl[4]; int gi = 0;
#pragma unroll
            for (int i = 0; i < 4; ++i) gl[i] = lg[i] + c.p->in[I_MBG][l * 4 + i];
            float gm = gl[0];
#pragma unroll
            for (int i = 1; i < 4; ++i) if (gl[i] > gm) { gm = gl[i]; gi = i; }
            float se = 0.f;
#pragma unroll
            for (int i = 0; i < 4; ++i) se += expf(gl[i] - gm);
            const float ptop = 1.0f / se;
            float el[8];
#pragma unroll
            for (int i = 0; i < 8; ++i) el[i] = lg[4 + gi * 8 + i] + c.p->in[I_MBE][l * 32 + gi * 8 + i];
            int e1 = 0; float m1 = el[0];
#pragma unroll
            for (int i = 1; i < 8; ++i) if (el[i] > m1) { m1 = el[i]; e1 = i; }
            int e2 = -1; float m2 = -3.0e38f;
#pragma unroll
            for (int i = 0; i < 8; ++i) if (i != e1 && el[i] > m2) { m2 = el[i]; e2 = i; }
            const float ex = expf(m2 - m1);
            const float w1 = ptop / (1.f + ex), w2 = ptop * ex / (1.f + ex);
            const int ea = gi * 8 + e1, eb = gi * 8 + e2;
            const int pa = atomicAdd(&lcnt[ea], 1), pb = atomicAdd(&lcnt[eb], 1);
            cSLOTPOS(c)[r * 2 + 0] = pa; cSLOTPOS(c)[r * 2 + 1] = pb;
            cROUTE_E(c)[r * 2 + 0] = ea; cROUTE_E(c)[r * 2 + 1] = eb;
            cROUTE_W(c)[r * 2 + 0] = w1; cROUTE_W(c)[r * 2 + 1] = w2;
        }
    }
    __syncthreads();
    if (tid < 32) lcnt[32 + tid] = atomicAdd(&cCNT(c)[(l * 32 + tid) * 64], lcnt[tid]);
    __syncthreads();
    for (int i = tid; i < cnt * 2; i += NT) {
        const int idx = row0 * 2 + i;
        const int e = cROUTE_E(c)[idx], pos = lcnt[32 + e] + cSLOTPOS(c)[idx];
        cSLOTPOS(c)[idx] = pos; cSLOTTOK(c)[(size_t)e * SLOTCAP + pos] = idx;
    }
}

struct InprojSched {
    const char* A; const char* Bt; int G, c, l, ldb, sw;
    __device__ __forceinline__ int tile(int q) const { return sw ? (q < 4 ? 2 + q : 6 + q) : (q < 2 ? q : (q < 6 ? 4 + q : 10 + q)); }
    __device__ __forceinline__ bool next(int i, pg::Unit& u) const {
        const int Lx = i * G + c, nN = sw ? 10 : 18;
        if (Lx < 64 * nN) { int q; pg::static_tile(Lx, 64, nN, u.pm, q); u.pn = tile(q); }
        else {
            const int j = Lx - 64 * nN;
            if (l == 0) { if (j >= 4 * nN) return false; u.pm = 64 + j / nN; u.pn = tile(j % nN); }
            else if (sw) { if (j >= 4 * 4) return false; u.pm = 64 + (j >> 2); u.pn = 2 + (j & 3); }
            else { if (j >= 4 * 2) return false; u.pm = 64 + (j >> 1); u.pn = 8 + (j & 1); }
        }
        u.a = A + (size_t)u.pm * 256 * D * 2; u.b = Bt + (size_t)u.pn * 256 * D * 2; u.aux = 0; u.swap = sw;
        return true;
    }
    __device__ __forceinline__ unsigned a_off(const pg::Unit&, int h, int R, int C) const { return (unsigned)(((h * 128 + R) * D + C) * 2); }
};
struct InprojEpiN {
    static constexpr bool MID = false;
    bf16_t *QP, *KR, *AO, *KT2, *BO, *ZG, *AY, *ZHYT, *ZHYTC, *ZGATE; const float* dec;
    __device__ __forceinline__ void operator()(const pg::f32x4 (&acc)[2][2][4][2], const pg::Unit& u, int wr, int wc, int fr, int fq) const {
        const int pn = u.pn, pm = u.pm;
        const int b = pm < 64 ? (pm >> 4) : (pm - 64), chunk = pm < 64 ? 1 + (pm & 15) : 0;
        if (pn < 2) {
#pragma unroll
            for (int bj = 0; bj < 2; ++bj) {
                const int h = 2 * pn + bj, bch = (b * 4 + h) * 17 + chunk, dk0 = wc * 32 + 8 * fq;
                const float lgf = dec[h], lgb = dec[4 + h];
#pragma unroll
                for (int ai = 0; ai < 2; ++ai)
#pragma unroll
                    for (int m = 0; m < 4; ++m) {
                        const int i = ai * 128 + wr * 64 + m * 16 + fr;
                        const float sf = __expf(lgf * (float)(i + 1)), sb = __expf(lgb * (float)(256 - i));
                        pg::f32x4 v0 = acc[ai][bj][m][0] * 0.08838834764831845f, v1 = acc[ai][bj][m][1] * 0.08838834764831845f;
                        *(pg::u32x4*)(QP + ((size_t)bch * 256 + i) * 128 + dk0) = pack8(v0, v1);
                        bf16_t* ao = AO + ((size_t)bch * 256 + i) * 512 + dk0;
                        *(pg::u32x4*)(ao + 256) = pack8(v0 * sf, v1 * sf);
                        *(pg::u32x4*)(ao + 384) = pack8(v0 * sb, v1 * sb);
                        __builtin_amdgcn_sched_barrier(0);
                    }
            }
        } else {
            const int row0 = pm * 256 + wr * 64 + fr, cc0 = wc * 32 + 8 * fq;
#pragma unroll
            for (int ai = 0; ai < 2; ++ai)
#pragma unroll
                for (int m = 0; m < 4; ++m) {
                    const int r = row0 + ai * 128 + m * 16;
#pragma unroll
                    for (int bj = 0; bj < 2; ++bj) {
                        const int cc = cc0 + bj * 128;
                        pg::f32x4 v0 = acc[ai][bj][m][0], v1 = acc[ai][bj][m][1];
                        if (pn < 8) { *(pg::u32x4*)(ZG + (size_t)r * 512 + (pn - 6) * 256 + cc) = pack8(v0, v1); }
                        else if (pn < 10) {
                            const int pos = r < RL ? 256 + (r & 4095) : ((r - RL) & 255);
                            const int ch = (pn - 8) * 256 + cc, g = ch >> 4, p0 = ch & 15;
                            *(pg::u32x4*)(AY + ((size_t)(g * 1280 + b * 272 + (pos >> 4)) * 512 + (pos & 15) * 16 + p0)) = pack8(v0, v1);
                        } else {
#pragma unroll
                            for (int e = 0; e < 4; ++e) { v0[e] = sigmoidf_(v0[e]); v1[e] = sigmoidf_(v1[e]); }
                            *(pg::u32x4*)(ZGATE + (size_t)r * 3072 + (pn - 16) * 256 + cc) = pack8(v0, v1);
                        }
                        __builtin_amdgcn_sched_barrier(0);
                    }
                }
        }
    }
};
struct InprojEpiT {
    static constexpr bool MID = false;
    bf16_t *QP, *KR, *AO, *KT2, *BO, *ZG, *AY, *ZHYT, *ZHYTC, *ZGATE; const float* dec;
    __device__ __forceinline__ void operator()(const pg::f32x4 (&acc)[2][2][4][2], const pg::Unit& u, int wr, int wc, int fr, int fq) const {
        const int pn = u.pn, pm = u.pm;
        const int b = pm < 64 ? (pm >> 4) : (pm - 64), chunk = pm < 64 ? 1 + (pm & 15) : 0;
        if (pn < 4) {
#pragma unroll
            for (int bj = 0; bj < 2; ++bj) {
                const int h = 2 * (pn - 2) + bj, bch = (b * 4 + h) * 17 + chunk;
                const float lgf = dec[h], lgb = dec[4 + h];
#pragma unroll
                for (int ai = 0; ai < 2; ++ai)
#pragma unroll
                    for (int m = 0; m < 4; ++m) {
                        const int j0 = ai * 128 + wr * 64 + m * 16 + 4 * fq;
                        float wf[4], wb[4];
#pragma unroll
                        for (int e = 0; e < 4; ++e) { wf[e] = __expf(lgf * (float)(255 - j0 - e)); wb[e] = __expf(lgb * (float)(j0 + e)); }
#pragma unroll
                        for (int n = 0; n < 2; ++n) {
                            const int dk = wc * 32 + 8 * (fr >> 2) + 4 * n + (fr & 3);
                            const pg::f32x4 v = acc[ai][bj][m][n];
#pragma unroll
                            for (int e = 0; e < 4; ++e) KR[((size_t)bch * 256 + j0 + e) * 128 + dk] = f2bf(v[e]);
                            pg::u32x2 w; w.x = pg::cvt_pk_bf16(v[0] * wf[0], v[1] * wf[1]); w.y = pg::cvt_pk_bf16(v[2] * wf[2], v[3] * wf[3]);
                            *(pg::u32x2*)(KT2 + ((size_t)bch * 256 + dk) * 256 + j0) = w;
                            w.x = pg::cvt_pk_bf16(v[0] * wb[0], v[1] * wb[1]); w.y = pg::cvt_pk_bf16(v[2] * wb[2], v[3] * wb[3]);
                            *(pg::u32x2*)(KT2 + ((size_t)bch * 256 + 128 + dk) * 256 + j0) = w;
                            __builtin_amdgcn_sched_barrier(0);
                        }
                    }
            }
        } else if (pn < 6) {
#pragma unroll
            for (int bj = 0; bj < 2; ++bj) {
                const int h = 2 * (pn - 4) + bj, bch = (b * 4 + h) * 17 + chunk;
#pragma unroll
                for (int ai = 0; ai < 2; ++ai)
#pragma unroll
                    for (int m = 0; m < 4; ++m) {
                        const int j0 = ai * 128 + wr * 64 + m * 16 + 4 * fq;
#pragma unroll
                        for (int n = 0; n < 2; ++n) {
                            const int dv = wc * 32 + 8 * (fr >> 2) + 4 * n + (fr & 3);
                            const pg::f32x4 v = acc[ai][bj][m][n];
                            pg::u32x2 w; w.x = pg::cvt_pk_bf16(v[0], v[1]); w.y = pg::cvt_pk_bf16(v[2], v[3]);
                            *(pg::u32x2*)(BO + ((size_t)bch * 128 + dv) * 512 + j0) = w;
                            __builtin_amdgcn_sched_barrier(0);
                        }
                    }
            }
        } else {
#pragma unroll
            for (int bj = 0; bj < 2; ++bj)
#pragma unroll
                for (int ai = 0; ai < 2; ++ai)
#pragma unroll
                    for (int m = 0; m < 4; ++m) {
                        const int i0 = ai * 128 + wr * 64 + m * 16 + 4 * fq;
#pragma unroll
                        for (int n = 0; n < 2; ++n) {
                            const int hc = (pn - 10) * 256 + bj * 128 + wc * 32 + 8 * (fr >> 2) + 4 * n + (fr & 3);
                            const pg::f32x4 v = acc[ai][bj][m][n];
                            pg::u32x2 w; w.x = pg::cvt_pk_bf16(v[0], v[1]); w.y = pg::cvt_pk_bf16(v[2], v[3]);
                            if (pm < 64) *(pg::u32x2*)(ZHYT + ((size_t)(hc * 4 + b) * 4096) + (pm & 15) * 256 + i0) = w;
                            else *(pg::u32x2*)(ZHYTC + ((size_t)(hc * 4 + b) * 256) + i0) = w;
                            __builtin_amdgcn_sched_barrier(0);
                        }
                    }
        }
    }
};
__device__ __forceinline__ void phase_inproj(const Ctx& c, int l) {
    { InprojSched S{(const char*)cH(c), (const char*)cWINT(c), c.nblk, c.bid, l, 1024, 0};
      InprojEpiN E{cQP(c), cKR(c), cAO(c), cKT2(c), cBO(c), cZG(c), cAY(c), cZHYT(c), cZHYTC(c), cZGATE(c), c.p->in[I_RETDEC] + l * 8};
      pg::gemm_phase<false>((PG_LAS unsigned char*)c.smem, D, S, E, opq(c.tid)); }
    { InprojSched S{(const char*)cH(c), (const char*)cWINT(c), c.nblk, c.bid, l, 1024, 1};
      InprojEpiT E{cQP(c), cKR(c), cAO(c), cKT2(c), cBO(c), cZG(c), cAY(c), cZHYT(c), cZHYTC(c), cZGATE(c), c.p->in[I_RETDEC] + l * 8};
      pg::gemm_phase<true>((PG_LAS unsigned char*)c.smem, D, S, E, opq(c.tid)); }
}

struct RetSched {
    const char* A; const char* Bt; int G, c, mode, l, ldb;
    __device__ __forceinline__ bool next(int i, pg::Unit& u) const {
        const int Lx = i * G + c;
        int bch;
        if (mode == 2 || l == 0) { if (Lx >= 272) return false; bch = Lx; }
        else { if (Lx >= 256) return false; bch = (Lx >> 4) * 17 + 1 + (Lx & 15); }
        u.pm = bch; u.pn = 0; u.aux = bch; u.swap = (mode == 2) ? 1 : 0;
        if (mode == 1) { u.a = A + (size_t)bch * 256 * 128 * 2; u.b = Bt + (size_t)bch * 256 * 128 * 2; }
        else if (mode == 2) { u.a = A + (size_t)bch * 256 * 256 * 2; u.b = Bt + (size_t)bch * 128 * 512 * 2; }
        else { u.a = A + (size_t)bch * 256 * 512 * 2; u.b = Bt + (size_t)bch * 128 * 512 * 2; }
        return true;
    }
    __device__ __forceinline__ unsigned a_off(const pg::Unit&, int h, int R, int C) const {
        const int lda = mode == 1 ? 128 : (mode == 2 ? 256 : 512);
        return (unsigned)(((h * 128 + R) * lda + C) * 2);
    }
};
struct RetU1Epi {
    static constexpr bool MID = false;
    bf16_t* AO; const float* dec;
    __device__ __forceinline__ void operator()(const pg::f32x4 (&acc)[2][2][4][2], const pg::Unit& u, int wr, int wc, int fr, int fq) const {
        const int bch = u.aux, h = (bch / 17) & 3;
        const float lgf = dec[h], lgb = dec[4 + h];
#pragma unroll
        for (int ai = 0; ai < 2; ++ai)
#pragma unroll
            for (int m = 0; m < 4; ++m) {
                const int i = ai * 128 + wr * 64 + m * 16 + fr;
#pragma unroll
                for (int bj = 0; bj < 2; ++bj) {
                    const int j0 = bj * 128 + wc * 32 + 8 * fq;
                    pg::f32x4 v0 = acc[ai][bj][m][0], v1 = acc[ai][bj][m][1];
#pragma unroll
                    for (int e = 0; e < 4; ++e) {
                        const int ja = j0 + e, jb = j0 + 4 + e;
                        v0[e] *= __expf((ja <= i) ? lgf * (float)(i - ja) : lgb * (float)(ja - i));
                        v1[e] *= __expf((jb <= i) ? lgf * (float)(i - jb) : lgb * (float)(jb - i));
                    }
                    *(pg::u32x4*)(AO + ((size_t)bch * 256 + i) * 512 + j0) = pack8(v0, v1);
                    __builtin_amdgcn_sched_barrier(0);
                }
            }
    }
};
struct RetU2Epi {
    static constexpr bool MID = false;
    float* DST;
    __device__ __forceinline__ void operator()(const pg::f32x4 (&acc)[2][2][4][2], const pg::Unit& u, int wr, int wc, int fr, int fq) const {
        const int bch = u.aux;
#pragma unroll
        for (int m = 0; m < 4; ++m) {
            const int dv = wr * 64 + m * 16 + fr;
            float* dst = DST + ((size_t)bch * 128 + dv) * 256 + wc * 32 + 8 * fq;
#pragma unroll
            for (int bj = 0; bj < 2; ++bj) { *(pg::f32x4*)(dst + bj * 128) = acc[0][bj][m][0]; *(pg::f32x4*)(dst + bj * 128 + 4) = acc[0][bj][m][1]; }
        }
    }
};
struct RetU3Epi {
    static constexpr bool MID = false;
    bf16_t* YCAT; const bf16_t* ZG; const float* gn; PG_LAS float* part;
    __device__ __forceinline__ void operator()(const pg::f32x4 (&acc)[2][2][4][2], const pg::Unit& u, int wr, int wc, int fr, int fq) const {
        const int bch = u.aux, chunk = bch % 17, bh = bch / 17, b = bh >> 2, h = bh & 3;
        const int rbase = chunk == 0 ? RL + b * 256 : b * L + (chunk - 1) * 256;
        const int lane = fq * 16 + fr, col = h * 128 + wc * 32 + 8 * fq;
#pragma unroll
        for (int ai = 0; ai < 2; ++ai)
#pragma unroll
            for (int m = 0; m < 4; ++m) {
                const pg::f32x4 a0 = acc[ai][0][m][0], a1 = acc[ai][0][m][1];
                float s = (a0[0] + a0[1]) + (a0[2] + a0[3]) + (a1[0] + a1[1]) + (a1[2] + a1[3]);
                float q = (a0[0] * a0[0] + a0[1] * a0[1]) + (a0[2] * a0[2] + a0[3] * a0[3]) + (a1[0] * a1[0] + a1[1] * a1[1]) + (a1[2] * a1[2] + a1[3] * a1[3]);
                s += shx(s, 16, lane); q += shx(q, 16, lane); s += shx(s, 32, lane); q += shx(q, 32, lane);
                if (fq == 0) { const int i = ai * 128 + wr * 64 + m * 16 + fr; typedef float f32x2v __attribute__((ext_vector_type(2))); *(PG_LAS f32x2v*)(part + (i * 4 + wc) * 2) = (f32x2v){s, q}; }
            }
        asm volatile("s_waitcnt lgkmcnt(0)" ::: "memory"); __builtin_amdgcn_s_barrier(); asm volatile("" ::: "memory");
        float gv[8];
        { const float4 g0 = *(const float4*)(gn + col), g1 = *(const float4*)(gn + col + 4); gv[0] = g0.x; gv[1] = g0.y; gv[2] = g0.z; gv[3] = g0.w; gv[4] = g1.x; gv[5] = g1.y; gv[6] = g1.z; gv[7] = g1.w; }
#pragma unroll
        for (int ai = 0; ai < 2; ++ai)
#pragma unroll
            for (int m = 0; m < 4; ++m) {
                const int i = ai * 128 + wr * 64 + m * 16 + fr;
                const pg::f32x4 p0 = *(const PG_LAS pg::f32x4*)(part + i * 8), p1 = *(const PG_LAS pg::f32x4*)(part + i * 8 + 4);
                const float mu = ((p0[0] + p0[2]) + (p1[0] + p1[2])) * (1.f / 128.f);
                const float var = fmaxf(((p0[1] + p0[3]) + (p1[1] + p1[3])) * (1.f / 128.f) - mu * mu, 0.f);
                const float rinv = rsqrtf(var + 1e-5f);
                float g[8]; unpack8(*(const pg::u32x4*)(ZG + (size_t)(rbase + i) * 512 + col), g);
                const pg::f32x4 a0 = acc[ai][0][m][0], a1 = acc[ai][0][m][1];
                pg::f32x4 v0, v1;
#pragma unroll
                for (int e = 0; e < 4; ++e) { v0[e] = (a0[e] - mu) * rinv * gv[e] * siluf_(g[e]); v1[e] = (a1[e] - mu) * rinv * gv[4 + e] * siluf_(g[4 + e]); }
                *(pg::u32x4*)(YCAT + (size_t)(rbase + i) * 1536 + col) = pack8(v0, v1);
            }
    }
};
__device__ __forceinline__ void ret_carry(const Ctx& c, int l) {
    const int gtid = c.bid * NT + c.tid, gthreads = c.nblk * NT;
    for (int idx = gtid; idx < 16 * 128 * 256; idx += gthreads) {
        const int bh = idx >> 15, dv = (idx >> 8) & 127, col = idx & 255, dir = col >> 7, h = bh & 3;
        const float g256 = __expf(256.f * c.p->in[I_RETDEC][(l * 2 + dir) * 4 + h]);
        float dd[17];
#pragma unroll
        for (int q = 0; q < 17; ++q) {
            const int chunk = dir == 0 ? q : (q == 0 ? 0 : 17 - q);
            dd[q] = cDST(c)[((size_t)(bh * 17 + chunk) * 128 + dv) * 256 + col];
        }
        float s = 0.f;
#pragma unroll
        for (int q = 0; q < 17; ++q) {
            const int chunk = dir == 0 ? q : (q == 0 ? 0 : 17 - q);
            cBO(c)[((size_t)(bh * 17 + chunk) * 128 + dv) * 512 + 256 + col] = f2bf(s);
            s = g256 * s + dd[q];
        }
    }
}
__device__ __forceinline__ void ret_finalize(const Ctx& c, int l) {
    const int gw = c.bid * 8 + c.wave, nw = c.nblk * 8;
    const int nrows = (l == 0) ? R : RL;
    for (int r = gw; r < nrows; r += nw) {
        float o[8], g[8];
        unpack8(*(const pg::u32x4*)(cOR(c) + (size_t)r * 512 + c.lane * 8), o);
        unpack8(*(const pg::u32x4*)(cZG(c) + (size_t)r * 512 + c.lane * 8), g);
        float s = 0.f;
#pragma unroll
        for (int i = 0; i < 8; ++i) s += o[i];
#pragma unroll
        for (int ofs = 8; ofs >= 1; ofs >>= 1) s += shx(s, ofs, c.lane);
        const float mu = s * (1.f / 128.f);
        float vs = 0.f;
#pragma unroll
        for (int i = 0; i < 8; ++i) { const float dlt = o[i] - mu; vs += dlt * dlt; }
#pragma unroll
        for (int ofs = 8; ofs >= 1; ofs >>= 1) vs += shx(vs, ofs, c.lane);
        const float rinv = rsqrtf(vs * (1.f / 128.f) + 1e-5f);
        const float* gn = c.p->in[I_RETGN] + l * 512 + c.lane * 8;
        pg::f32x4 v0, v1;
#pragma unroll
        for (int i = 0; i < 4; ++i) { v0[i] = (o[i] - mu) * rinv * gn[i] * siluf_(g[i]); v1[i] = (o[4 + i] - mu) * rinv * gn[4 + i] * siluf_(g[4 + i]); }
        *(pg::u32x4*)(cYCAT(c) + (size_t)r * 1536 + c.lane * 8) = pack8(v0, v1);
    }
}

constexpr int HY_LENC = 4240, HY_UB = 8 * HY_LENC * 2, HY_LU = 4616, HY_X0 = HY_UB + 4 * HY_LU * 2;
typedef float f32x16 __attribute__((ext_vector_type(16)));
__device__ __forceinline__ void hy_conv3v(const pg::u32x4& w, float xm, float xp, float w0, float w1, float w2, float bs, float (&o)[8]) {
    float x[10];
    unpack8(w, *(float (*)[8])&x[1]); x[0] = xm; x[9] = xp;
#pragma unroll
    for (int j = 0; j < 8; ++j) o[j] = bs + w0 * x[j] + w1 * x[j + 1] + w2 * x[j + 2];
}
__device__ __forceinline__ void hy_channel(const Ctx& c, int l, int ch, const bool isctx) {
    PG_LAS unsigned char* lds = (PG_LAS unsigned char*)c.smem;
    const int tid = c.tid, lane = c.lane, wave = c.wave;
    const int Lq = isctx ? LC : L, half = Lq / 2;
    const bf16_t* hsrc = isctx ? cFILTC(c) + (size_t)ch * LC : cFILT(c) + ((size_t)l * 512 + ch) * L;
    const bf16_t* zbase = isctx ? cZHYTC(c) : cZHYT(c);
    __syncthreads();
    PG_LAS bf16_t* hst = (PG_LAS bf16_t*)(lds + HY_X0 + 4 * 4096 * 2);
    if (tid * 8 < Lq) *(PG_LAS pg::u32x4*)(hst + tid * 8) = *(const pg::u32x4*)(hsrc + tid * 8);
    __syncthreads();
    const int nch = isctx ? 48 : 530;
    for (int i = tid; i < nch; i += NT) {
        const int c0i = Lq / 8 + 7 - i, c1i = c0i - 1;
        pg::u32x4 h0v = (pg::u32x4){0u, 0u, 0u, 0u}, h1v = h0v;
        if (c0i >= 0 && c0i < Lq / 8) h0v = *(const PG_LAS pg::u32x4*)(hst + c0i * 8);
        if (c1i >= 0 && c1i < Lq / 8) h1v = *(const PG_LAS pg::u32x4*)(hst + c1i * 8);
        unsigned cat[9];
#pragma unroll
        for (int j = 0; j < 4; ++j) { const unsigned a = h0v[3 - j], b = h1v[3 - j]; cat[j] = (a >> 16) | (a << 16); cat[4 + j] = (b >> 16) | (b << 16); }
        cat[8] = 0u;
#pragma unroll
        for (int s = 0; s < 8; ++s) {
            pg::u32x4 o;
#pragma unroll
            for (int j = 0; j < 4; ++j) o[j] = (s & 1) ? ((cat[j + (s >> 1)] >> 16) | (cat[j + (s >> 1) + 1] << 16)) : cat[j + (s >> 1)];
            *(PG_LAS pg::u32x4*)(lds + s * (HY_LENC * 2) + i * 16) = o;
        }
    }
    {
        const float* sw = c.p->in[I_HYSW] + (size_t)l * 3 * 1536; const float* sb = c.p->in[I_HYSB] + l * 1536;
        const float a0 = sw[ch], a1 = sw[1536 + ch], a2 = sw[3072 + ch], ab = sb[ch];
        const float b0 = sw[512 + ch], b1 = sw[1536 + 512 + ch], b2 = sw[3072 + 512 + ch], bb = sb[512 + ch];
        const float c0 = sw[1024 + ch], c1 = sw[1536 + 1024 + ch], c2 = sw[3072 + 1024 + ch], cb = sb[1024 + ch];
        const int cpb = Lq / 8, nit = isctx ? 1 : 4;
        pg::u32x4 wv[4][3];
        float em[4][3], ep[4][3];
#pragma unroll
        for (int it = 0; it < 4; ++it) {
            if (it < nit) {
                const int idx = tid + it * NT, b = idx / cpb, t8 = (idx % cpb) * 8;
                const bool act = idx < 4 * cpb;
#pragma unroll
                for (int q = 0; q < 3; ++q) {
                    const bf16_t* z = zbase + (size_t)((q * 512 + ch) * 4 + (act ? b : 0)) * Lq;
                    wv[it][q] = act ? *(const pg::u32x4*)(z + t8) : (pg::u32x4){0u, 0u, 0u, 0u};
                    em[it][q] = (act && lane == 0 && t8 > 0) ? bf2f(z[t8 - 1]) : 0.f;
                    ep[it][q] = (act && lane == 63 && t8 + 8 < Lq) ? bf2f(z[t8 + 8]) : 0.f;
                }
            }
        }
#pragma unroll
        for (int it = 0; it < 4; ++it) {
            if (it < nit) {
                const int idx = tid + it * NT, b = idx / cpb, t8 = (idx % cpb) * 8;
                float xq[3][8];
#pragma unroll
                for (int q = 0; q < 3; ++q) {
                    const unsigned up = (unsigned)__builtin_amdgcn_ds_bpermute(((lane + 63) & 63) << 2, (int)wv[it][q][3]);
                    const unsigned dn = (unsigned)__builtin_amdgcn_ds_bpermute(((lane + 1) & 63) << 2, (int)wv[it][q][0]);
                    const float xm = lane == 0 ? em[it][q] : (t8 > 0 ? __uint_as_float(up & 0xffff0000u) : 0.f);
                    const float xp = lane == 63 ? ep[it][q] : (t8 + 8 < Lq ? __uint_as_float(dn << 16) : 0.f);
                    hy_conv3v(wv[it][q], xm, xp, q == 0 ? a0 : (q == 1 ? b0 : c0), q == 0 ? a1 : (q == 1 ? b1 : c1), q == 0 ? a2 : (q == 1 ? b2 : c2), q == 0 ? ab : (q == 1 ? bb : cb), xq[q]);
                }
                if (idx < 4 * cpb) {
                    pg::f32x4 u0, u1, y0, y1;
#pragma unroll
                    for (int j = 0; j < 4; ++j) { u0[j] = xq[1][j] * xq[2][j]; u1[j] = xq[1][4 + j] * xq[2][4 + j]; y0[j] = xq[0][j]; y1[j] = xq[0][4 + j]; }
                    *(PG_LAS pg::u32x4*)(lds + HY_UB + (b * HY_LU + 256 + t8) * 2) = pack8(u0, u1);
                    *(PG_LAS pg::u32x4*)(lds + HY_X0 + (b * 4096 + t8) * 2) = pack8(y0, y1);
                }
            }
        }
        if (isctx) for (int idx = tid; idx < 4 * 32; idx += NT) *(PG_LAS pg::u32x4*)(lds + HY_UB + ((idx >> 5) * HY_LU + 512 + (idx & 31) * 8) * 2) = (pg::u32x4){0u, 0u, 0u, 0u};
    }
    __syncthreads();
    const int r = lane & 31, hh = lane >> 5, i_n = r >> 2, bq = r & 3;
    const float bias = c.p->in[I_HYBIAS][l * 512 + ch];
    bf16_t* ydst = isctx ? cYHYTC(c) + (size_t)(ch * 4 + bq) * LC : cYHYT(c) + (size_t)(ch * 4 + bq) * L;
    const int ntile = isctx ? (wave == 0 ? 1 : 0) : 2;
#pragma unroll 1
    for (int ts = 0; ts < ntile; ++ts) {
        const int T0 = (ts ? 15 - wave : wave) * 256;
        int dlo = -(half + 16), dhi = half;
        if (T0 - (Lq - 16) > dlo) dlo = T0 - (Lq - 16);
        if (T0 + 224 < dhi) dhi = T0 + 224;
        const int nst = (dhi - dlo) / 16 + 1;
        const int qq = 64 + Lq - 1 - half - dlo - r + 8 * hh, s = qq & 7;
        const PG_LAS unsigned char* pA = lds + s * (HY_LENC * 2) + (qq - s) * 2;
        const PG_LAS unsigned char* pB = lds + HY_UB + (bq * HY_LU + 256 + T0 + 32 * i_n - dlo + 8 * hh) * 2;
        f32x16 acc;
#pragma unroll
        for (int i = 0; i < 16; ++i) acc[i] = 0.f;
        {
            pg::bf16x8 fa[4], fb[4];
#pragma unroll
            for (int k = 0; k < 4; ++k) { const int sk = k < nst ? k : nst - 1; fa[k] = *(const PG_LAS pg::bf16x8*)(pA - 32 * sk); fb[k] = *(const PG_LAS pg::bf16x8*)(pB - 32 * sk); }
            int st = 0;
#pragma unroll 1
            for (; st + 4 <= nst; st += 4) {
                pg::bf16x8 na[4], nb[4];
#pragma unroll
                for (int k = 0; k < 4; ++k) { const int sk = st + 4 + k < nst ? st + 4 + k : nst - 1; na[k] = *(const PG_LAS pg::bf16x8*)(pA - 32 * sk); nb[k] = *(const PG_LAS pg::bf16x8*)(pB - 32 * sk); }
#pragma unroll
                for (int k = 0; k < 4; ++k) acc = __builtin_amdgcn_mfma_f32_32x32x16_bf16(fa[k], fb[k], acc, 0, 0, 0);
#pragma unroll
                for (int k = 0; k < 4; ++k) { fa[k] = na[k]; fb[k] = nb[k]; }
            }
            if (st < nst) acc = __builtin_amdgcn_mfma_f32_32x32x16_bf16(fa[0], fb[0], acc, 0, 0, 0);
            if (st + 1 < nst) acc = __builtin_amdgcn_mfma_f32_32x32x16_bf16(fa[1], fb[1], acc, 0, 0, 0);
            if (st + 2 < nst) acc = __builtin_amdgcn_mfma_f32_32x32x16_bf16(fa[2], fb[2], acc, 0, 0, 0);
        }
#pragma unroll
        for (int q = 0; q < 4; ++q) {
            const int t = T0 + 32 * i_n + 8 * q + 4 * hh;
            const pg::u32x2 uw = *(const PG_LAS pg::u32x2*)(lds + HY_UB + (bq * HY_LU + 256 + t) * 2);
            const pg::u32x2 xw = *(const PG_LAS pg::u32x2*)(lds + HY_X0 + (bq * 4096 + t) * 2);
            const float u0 = __uint_as_float(uw.x << 16), u1 = __uint_as_float(uw.x & 0xffff0000u), u2 = __uint_as_float(uw.y << 16), u3 = __uint_as_float(uw.y & 0xffff0000u);
            const float x0 = __uint_as_float(xw.x << 16), x1 = __uint_as_float(xw.x & 0xffff0000u), x2 = __uint_as_float(xw.y << 16), x3 = __uint_as_float(xw.y & 0xffff0000u);
            pg::u32x2 o; o.x = pg::cvt_pk_bf16(x0 * (acc[4 * q] + u0 * bias), x1 * (acc[4 * q + 1] + u1 * bias)); o.y = pg::cvt_pk_bf16(x2 * (acc[4 * q + 2] + u2 * bias), x3 * (acc[4 * q + 3] + u3 * bias));
            *(pg::u32x2*)(ydst + t) = o;
        }
    }
}
__device__ __forceinline__ void hy_phase(const Ctx& c, int l) {
    PG_LAS unsigned char* lds = (PG_LAS unsigned char*)c.smem;
    __syncthreads();
    for (int idx = c.tid; idx < 4 * 64; idx += NT) {
        const int b = idx >> 6, k = idx & 63;
        const int e = k < 32 ? k * 8 : 4352 + (k - 32) * 8;
        *(PG_LAS pg::u32x4*)(lds + HY_UB + (b * HY_LU + e) * 2) = (pg::u32x4){0u, 0u, 0u, 0u};
    }
#pragma unroll 1
    for (int ch = c.bid; ch < 512; ch += c.nblk) hy_channel(c, l, ch, false);
    if (l == 0) {
#pragma unroll 1
        for (int ch = c.bid; ch < 512; ch += c.nblk) hy_channel(c, l, ch, true);
    }
}
__device__ __forceinline__ void hy_transpose(const Ctx& c, int l, int rank, int nrank) {
    bf16_t* tile = (bf16_t*)c.smem;
    const int nit = 2048 + (l == 0 ? 128 : 0);
#pragma unroll 1
    for (int it = rank; it < nit; it += nrank) {
        int b, t0, c0, Lq; const bf16_t* srcb; size_t rowbase;
        if (it < 2048) { b = it >> 9; t0 = ((it >> 3) & 63) * 64; c0 = (it & 7) * 64; Lq = L; srcb = cYHYT(c); rowbase = (size_t)b * L; }
        else { const int k = it - 2048; b = k >> 5; t0 = ((k >> 3) & 3) * 64; c0 = (k & 7) * 64; Lq = LC; srcb = cYHYTC(c); rowbase = (size_t)RL + b * LC; }
        __syncthreads();
        { const int cc = c.tid >> 3, t8 = (c.tid & 7) * 8;
          *(uint4*)(tile + cc * 72 + t8) = *(const uint4*)(srcb + (size_t)((c0 + cc) * 4 + b) * Lq + t0 + t8); }
        __syncthreads();
        { const int tp = c.tid & 31, cg = c.tid >> 5;
          unsigned w[4];
#pragma unroll
          for (int j = 0; j < 4; ++j) w[j] = *(const unsigned*)(tile + (cg * 4 + j) * 72 + tp * 2);
          bf16_t* dst = cYCAT(c) + (rowbase + t0 + tp * 2) * 1536 + 1024 + c0 + cg * 4;
          *(uint2*)dst = make_uint2((w[0] & 0xffffu) | (w[1] << 16), (w[2] & 0xffffu) | (w[3] << 16));
          *(uint2*)(dst + 1536) = make_uint2((w[0] >> 16) | (w[1] & 0xffff0000u), (w[2] >> 16) | (w[3] & 0xffff0000u)); }
    }
}

__device__ __forceinline__ void s5_param_item(const Ctx& c, int l, int g) {
    float* ap = c.smem;
    float* Bb = ap + 2 * 17 * 130;
    float* Cc = Bb + 2 * 64 * 16 * 2;
    float* Kt = Cc + 2 * 16 * 130;
    const int tid = c.tid;
    __syncthreads();
    if (tid < 128) {
        const int d = tid >> 6, n = tid & 63, pg_ = (l * 2 + d) * 32 + g;
        const float lr = c.p->in[I_LRE][pg_ * 64 + n], li = c.p->in[I_LIM][pg_ * 64 + n], dt = expf(c.p->in[I_LOGDT][pg_]);
        for (int j = 0; j <= 16; ++j) { const float er = __expf((float)j * lr * dt), ang = (float)j * li * dt; ap[(d * 17 + j) * 130 + n * 2] = er * __cosf(ang); ap[(d * 17 + j) * 130 + n * 2 + 1] = er * __sinf(ang); }
        const float ar = expf(lr * dt) * cosf(li * dt), ai = expf(lr * dt) * sinf(li * dt);
        const float nr = ar - 1.f, ni = ai, den = lr * lr + li * li;
        const float cr = (nr * lr + ni * li) / den, ci = (ni * lr - nr * li) / den;
        for (int q = 0; q < 16; ++q) {
            const float br = c.p->in[I_BRE][((size_t)pg_ * 64 + n) * 16 + q], bi = c.p->in[I_BIM][((size_t)pg_ * 64 + n) * 16 + q];
            Bb[((d * 64 + n) * 16 + q) * 2] = cr * br - ci * bi; Bb[((d * 64 + n) * 16 + q) * 2 + 1] = cr * bi + ci * br;
        }
    }
    for (int i = tid; i < 2 * 16 * 64; i += NT) {
        const int d = i >> 10, q = (i >> 6) & 15, n = i & 63, pg_ = (l * 2 + d) * 32 + g;
        Cc[(d * 16 + q) * 130 + n * 2] = c.p->in[I_CRE][((size_t)pg_ * 16 + q) * 64 + n]; Cc[(d * 16 + q) * 130 + n * 2 + 1] = c.p->in[I_CIM][((size_t)pg_ * 16 + q) * 64 + n];
    }
    __syncthreads();
    {
        const int d = tid >> 8, j = (tid >> 4) & 15, p = tid & 15;
        float s[16];
#pragma unroll
        for (int q = 0; q < 16; ++q) s[q] = 0.f;
        for (int n = 0; n < 64; ++n) {
            const float xr = Cc[(d * 16 + p) * 130 + n * 2], xi = Cc[(d * 16 + p) * 130 + n * 2 + 1];
            const float pr = ap[(d * 17 + j) * 130 + n * 2], pi = ap[(d * 17 + j) * 130 + n * 2 + 1];
            const float zr = xr * pr - xi * pi, zi = xr * pi + xi * pr;
#pragma unroll
            for (int q = 0; q < 16; ++q) s[q] += zr * Bb[((d * 64 + n) * 16 + q) * 2] - zi * Bb[((d * 64 + n) * 16 + q) * 2 + 1];
        }
#pragma unroll
        for (int q = 0; q < 16; ++q) Kt[((d * 16 + j) * 16 + p) * 16 + q] = s[q];
    }
    __syncthreads();
    bf16_t* PE = cPE(c) + (size_t)(l * 32 + g) * 256 * 256;
#pragma unroll 2
    for (int gi = tid; gi < 256 * 32; gi += NT) {
        const int row = gi >> 5, kg = gi & 31, d = row >> 7, ri = (row >> 6) & 1, n = row & 63, sg = kg >> 1, p0 = (kg & 1) * 8;
        const int e = d == 0 ? 15 - sg : sg;
        const float2 pw = *(const float2*)&ap[(d * 17 + e) * 130 + n * 2];
        const float4* bb = (const float4*)&Bb[((d * 64 + n) * 16 + p0) * 2];
        pg::f32x4 v0, v1;
#pragma unroll
        for (int j = 0; j < 4; ++j) {
            const float4 b2 = bb[j];
            const float o0 = ri ? (pw.x * b2.y + pw.y * b2.x) : (pw.x * b2.x - pw.y * b2.y);
            const float o1 = ri ? (pw.x * b2.w + pw.y * b2.z) : (pw.x * b2.z - pw.y * b2.w);
            if (j < 2) { v0[2 * j] = o0; v0[2 * j + 1] = o1; } else { v1[2 * j - 4] = o0; v1[2 * j - 3] = o1; }
        }
        *(pg::u32x4*)(PE + (size_t)row * 256 + kg * 8) = pack8(v0, v1);
    }
    bf16_t* PY = cPY(c) + (size_t)(l * 32 + g) * 256 * 512;
#pragma unroll 2
    for (int gi = tid; gi < 256 * 64; gi += NT) {
        const int row = gi >> 6, kg = gi & 63, tau = row >> 4, p = row & 15;
        pg::f32x4 v0 = {0.f, 0.f, 0.f, 0.f}, v1 = {0.f, 0.f, 0.f, 0.f};
        if (kg < 32) {
            const int sg = kg >> 1, q0 = (kg & 1) * 8;
            if (sg <= tau) { const float4* kp = (const float4*)&Kt[((0 * 16 + (tau - sg)) * 16 + p) * 16 + q0]; const float4 a = kp[0], b = kp[1]; v0[0] += a.x; v0[1] += a.y; v0[2] += a.z; v0[3] += a.w; v1[0] += b.x; v1[1] += b.y; v1[2] += b.z; v1[3] += b.w; }
            if (sg >= tau) { const float4* kp = (const float4*)&Kt[((1 * 16 + (sg - tau)) * 16 + p) * 16 + q0]; const float4 a = kp[0], b = kp[1]; v0[0] += a.x; v0[1] += a.y; v0[2] += a.z; v0[3] += a.w; v1[0] += b.x; v1[1] += b.y; v1[2] += b.z; v1[3] += b.w; }
        } else {
            const int kk0 = kg * 8 - 256, d = kk0 >> 7, ri = (kk0 >> 6) & 1, n0 = kk0 & 63;
            const int e = d == 0 ? tau + 1 : 16 - tau;
            const float2* xc = (const float2*)&Cc[(d * 16 + p) * 130 + n0 * 2];
            const float2* pa = (const float2*)&ap[(d * 17 + e) * 130 + n0 * 2];
#pragma unroll
            for (int j = 0; j < 8; ++j) {
                const float2 x = xc[j], pw = pa[j];
                const float o = ri ? -(x.x * pw.y + x.y * pw.x) : (x.x * pw.x - x.y * pw.y);
                if (j < 4) v0[j] = o; else v1[j - 4] = o;
            }
        }
        *(pg::u32x4*)(PY + (size_t)row * 512 + kg * 8) = pack8(v0, v1);
    }
}
struct S5Sched {
    const char* AY; const char* P; int G, c, K, ldb;
    __device__ __forceinline__ bool next(int i, pg::Unit& u) const {
        const int Lx = i * G + c; if (Lx >= 160) return false;
        const int g = Lx / 5, rt = Lx % 5;
        u.pm = rt; u.pn = 0; u.aux = g; u.swap = 0;
        u.a = AY + ((size_t)(g * 1280 + rt * 256) * 512) * 2; u.b = P + (size_t)g * 256 * K * 2; return true;
    }
    __device__ __forceinline__ unsigned a_off(const pg::Unit&, int h, int R, int C) const { return (unsigned)(((h * 128 + R) * 512 + C) * 2); }
};
struct S5EEpi {
    static constexpr bool MID = false;
    float* EOUT;
    __device__ __forceinline__ void operator()(const pg::f32x4 (&acc)[2][2][4][2], const pg::Unit& u, int wr, int wc, int fr, int fq) const {
        const int row0 = u.pm * 256 + wr * 64 + fr, col0 = wc * 32 + 8 * fq;
#pragma unroll
        for (int ai = 0; ai < 2; ++ai)
#pragma unroll
            for (int m = 0; m < 4; ++m) {
                const int r = row0 + ai * 128 + m * 16;
                if (r < 1088) {
                    float* dst = EOUT + ((size_t)u.aux * 1088 + r) * 256 + col0;
#pragma unroll
                    for (int bj = 0; bj < 2; ++bj) { *(pg::f32x4*)(dst + bj * 128) = acc[ai][bj][m][0]; *(pg::f32x4*)(dst + bj * 128 + 4) = acc[ai][bj][m][1]; }
                }
            }
    }
};
__device__ __forceinline__ void phase_s5carry(const Ctx& c, int l) {
    float* loc = c.smem;
#pragma unroll 1
    for (int it = c.bid; it < 256; it += c.nblk) {
        const int g = it >> 3, b = (it >> 1) & 3, d = it & 1;
        const int n = c.tid & 63, sgp = c.tid >> 6;
        const int pg_ = (l * 2 + d) * 32 + g;
        const float lr = c.p->in[I_LRE][pg_ * 64 + n], li = c.p->in[I_LIM][pg_ * 64 + n], dt = expf(c.p->in[I_LOGDT][pg_]);
        const float e16 = expf(16.f * lr * dt), Ar = e16 * cosf(16.f * li * dt), Ai = e16 * sinf(16.f * li * dt);
        const float e34 = expf(544.f * lr * dt), Pr = e34 * cosf(544.f * li * dt), Pi = e34 * sinf(544.f * li * dt);
        const float* Eb = cEOUT(c) + ((size_t)g * 1088 + b * 272) * 256 + d * 128 + n;
        float sr = 0.f, si = 0.f;
#pragma unroll 1
        for (int hb = 0; hb < 2; ++hb) {
            float er[17], ei[17];
#pragma unroll
            for (int i = 0; i < 17; ++i) {
                const int q = sgp * 34 + hb * 17 + i;
                const int ch = d == 0 ? q : (q < 16 ? 15 - q : 287 - q);
                er[i] = Eb[ch * 256]; ei[i] = Eb[ch * 256 + 64];
            }
#pragma unroll
            for (int i = 0; i < 17; ++i) { const float tr = Ar * sr - Ai * si + er[i], ti = Ar * si + Ai * sr + ei[i]; sr = tr; si = ti; }
        }
        __syncthreads();
        loc[(sgp * 64 + n) * 2] = sr; loc[(sgp * 64 + n) * 2 + 1] = si;
        __syncthreads();
        float hr = 0.f, hi = 0.f;
        for (int s2 = 0; s2 < sgp; ++s2) { const float tr = Pr * hr - Pi * hi + loc[(s2 * 64 + n) * 2], ti = Pr * hi + Pi * hr + loc[(s2 * 64 + n) * 2 + 1]; hr = tr; hi = ti; }
        bf16_t* Ab = cAY(c) + ((size_t)(g * 1280 + b * 272)) * 512 + 256 + d * 128 + n;
#pragma unroll 1
        for (int hb = 0; hb < 2; ++hb) {
            float er[17], ei[17];
#pragma unroll
            for (int i = 0; i < 17; ++i) {
                const int q = sgp * 34 + hb * 17 + i;
                const int ch = d == 0 ? q : (q < 16 ? 15 - q : 287 - q);
                er[i] = Eb[ch * 256]; ei[i] = Eb[ch * 256 + 64];
            }
#pragma unroll
            for (int i = 0; i < 17; ++i) {
                const int q = sgp * 34 + hb * 17 + i;
                const int ch = d == 0 ? q : (q < 16 ? 15 - q : 287 - q);
                Ab[ch * 512] = f2bf(hr); Ab[ch * 512 + 64] = f2bf(hi);
                const float tr = Ar * hr - Ai * hi + er[i], ti = Ar * hi + Ai * hr + ei[i]; hr = tr; hi = ti;
            }
        }
    }
}
struct S5YEpi {
    static constexpr bool MID = false;
    const bf16_t* AY; bf16_t* G; const float* dvec; int l;
    __device__ __forceinline__ void operator()(const pg::f32x4 (&acc)[2][2][4][2], const pg::Unit& u, int wr, int wc, int fr, int fq) const {
        const int row0 = u.pm * 256 + wr * 64 + fr, col0 = wc * 32 + 8 * fq, g = u.aux;
#pragma unroll
        for (int ai = 0; ai < 2; ++ai)
#pragma unroll
            for (int m = 0; m < 4; ++m) {
                const int r = row0 + ai * 128 + m * 16;
                if (r < 1088) {
                    const int b = r / 272, chunk = r % 272;
#pragma unroll
                    for (int bj = 0; bj < 2; ++bj) {
                        const int cc = col0 + bj * 128, tau = cc >> 4, p0 = cc & 15, pos = chunk * 16 + tau;
                        if (pos < 256 && l == 1) continue;
                        const size_t grow = pos < 256 ? (size_t)(RL + b * 256 + pos) : (size_t)(b * L + pos - 256);
                        float uu[8]; unpack8(*(const pg::u32x4*)(AY + ((size_t)(g * 1280 + r) * 512 + cc)), uu);
                        const pg::f32x4 d0 = *(const pg::f32x4*)(dvec + g * 16 + p0), d1 = *(const pg::f32x4*)(dvec + g * 16 + p0 + 4);
                        pg::f32x4 v0, v1;
#pragma unroll
                        for (int e = 0; e < 4; ++e) {
                            const float x0 = acc[ai][bj][m][0][e] + d0[e] * uu[e], x1 = acc[ai][bj][m][1][e] + d1[e] * uu[4 + e];
                            v0[e] = gelu_tanh_(x0); v1[e] = gelu_tanh_(x1);
                        }
                        *(pg::u32x4*)(G + grow * 512 + g * 16 + p0) = pack8(v0, v1);
                    }
                }
            }
    }
};
struct MixASched {
    RetSched R1; S5Sched SE; const char* BO; const char* KT2; int G, c, n1;
    __device__ __forceinline__ bool next(int i, pg::Unit& u) const {
        int Lx = i * G + c;
        if (Lx < n1) { RetSched t = R1; t.G = 1; t.c = Lx; const bool ok = t.next(0, u); u.pn = 0; u.K = 128; u.ldb = 128; return ok; }
        Lx -= n1;
        if (Lx < 272) {
            u.pm = Lx; u.aux = Lx; u.swap = 0; u.pn = 2; u.K = 256; u.ldb = 256;
            u.a = BO + (size_t)Lx * 128 * 512 * 2; u.b = KT2 + (size_t)Lx * 256 * 256 * 2; return true; }
        Lx -= 272;
        S5Sched t = SE; t.G = 1; t.c = Lx; const bool ok = t.next(0, u); u.pn = 1; u.K = 256; u.ldb = 256; return ok;
    }
    __device__ __forceinline__ unsigned a_off(const pg::Unit& u, int h, int R_, int C) const { return (unsigned)(((h * 128 + R_) * (u.pn ? 512 : 128) + C) * 2); }
    __device__ __forceinline__ bool defer(const pg::Unit&) const { return false; }
    __device__ __forceinline__ bool try_ready(const pg::Unit&) const { return true; }
    __device__ __forceinline__ void wait_ready(const pg::Unit&, int) const {}
    __device__ __forceinline__ void publish(const pg::Unit&, int) const {}
};
struct MixAEpi {
    static constexpr bool MID = false;
    RetU1Epi E1; S5EEpi EE; RetU2Epi E2;
    __device__ __forceinline__ void operator()(const pg::f32x4 (&acc)[2][2][4][2], const pg::Unit& u, int wr, int wc, int fr, int fq) const {
        if (u.pn == 0) E1(acc, u, wr, wc, fr, fq);
        else if (u.pn == 2) E2(acc, u, wr, wc, fr, fq);
        else { pg::Unit v = u; v.pn = 0; EE(acc, v, wr, wc, fr, fq); }
    }
};
__device__ __forceinline__ void phase_mixA(const Ctx& c, int l) {
    MixASched S{RetSched{(const char*)cQP(c), (const char*)cKR(c), 1, 0, 1, l, 128}, S5Sched{(const char*)cAY(c), (const char*)(cPE(c) + (size_t)l * 32 * 256 * 256), 1, 0, 256, 256},
                (const char*)cBO(c), (const char*)cKT2(c), c.nblk, c.bid, (l == 0) ? 272 : 256};
    MixAEpi E{RetU1Epi{cAO(c), c.p->in[I_RETDEC] + l * 8}, S5EEpi{cEOUT(c)}, RetU2Epi{cDST(c)}};
    pg::gemm_phase_var((PG_LAS unsigned char*)c.smem, S, E, opq(c.tid));
}
__device__ __forceinline__ void phase_mixB(const Ctx& c, int l) {
    ret_carry(c, l);
    phase_s5carry(c, l);
    hy_phase(c, l);
}
struct MixCSched {
    RetSched R3; S5Sched SY; int G, c, n3, ldb;
    __device__ __forceinline__ bool next(int i, pg::Unit& u) const {
        const int Lx = i * G + c;
        if (Lx < n3) { RetSched t = R3; t.G = 1; t.c = Lx; const bool ok = t.next(0, u); u.pn = 0; return ok; }
        S5Sched t = SY; t.G = 1; t.c = Lx - n3; const bool ok = t.next(0, u); u.pn = 1; return ok;
    }
    __device__ __forceinline__ unsigned a_off(const pg::Unit&, int h, int R_, int C) const { return (unsigned)(((h * 128 + R_) * 512 + C) * 2); }
};
template <> struct pg::HalfB<MixCSched> { static constexpr bool v = true; static __device__ __forceinline__ bool full(const pg::Unit& u) { return u.pn != 0; } };
struct MixCEpi {
    static constexpr bool MID = false;
    RetU3Epi E3; S5YEpi EY;
    __device__ __forceinline__ void operator()(const pg::f32x4 (&acc)[2][2][4][2], const pg::Unit& u, int wr, int wc, int fr, int fq) const {
        if (u.pn == 0) E3(acc, u, wr, wc, fr, fq);
        else { pg::Unit v = u; v.pn = 0; EY(acc, v, wr, wc, fr, fq); }
    }
};
__device__ __forceinline__ void phase_mixC(const Ctx& c, int l) {
    MixCSched S{RetSched{(const char*)cAO(c), (const char*)cBO(c), 1, 0, 3, l, 512}, S5Sched{(const char*)cAY(c), (const char*)(cPY(c) + (size_t)l * 32 * 256 * 512), 1, 0, 512, 512},
                c.nblk, c.bid, (l == 0) ? 272 : 256, 512};
    MixCEpi E{RetU3Epi{cYCAT(c), cZG(c), c.p->in[I_RETGN] + l * 512, (PG_LAS float*)((PG_LAS unsigned char*)c.smem + LDS_SH + 4608)}, S5YEpi{cAY(c), cG(c), c.p->in[I_S5D] + l * 512, l}};
    pg::gemm_phase<false>((PG_LAS unsigned char*)c.smem, 512, S, E, opq(c.tid));
    { const int nu = (l == 0) ? 432 : 416, first = nu - c.nblk;
      if (first > 0 && first < c.nblk) { if (c.bid >= first) { __syncthreads(); hy_transpose(c, l, c.bid - first, c.nblk - first); } }
      else hy_transpose(c, l, c.bid, c.nblk); }
}

struct PlainSched {
    const char* A; const char* Bt; int G, c, nM, nN, lda, K, ldb;
    __device__ __forceinline__ bool next(int i, pg::Unit& u) const {
        const int Lx = i * G + c; if (Lx >= nM * nN) return false;
        pg::static_tile(Lx, nM, nN, u.pm, u.pn);
        u.a = A + (size_t)u.pm * 256 * lda * 2; u.b = Bt + (size_t)u.pn * 256 * K * 2; u.aux = 0; u.swap = 0; return true;
    }
    __device__ __forceinline__ unsigned a_off(const pg::Unit&, int h, int R, int C) const { return (unsigned)(((h * 128 + R) * lda + C) * 2); }
};
__device__ __forceinline__ void st16_wt(const __amdgpu_buffer_rsrc_t rs, unsigned byte_off, const pg::u32x4& v) { __builtin_amdgcn_raw_buffer_store_b128(v, rs, byte_off, 0, 16); }
struct GluEpi {
    static constexpr bool MID = false;
    bf16_t* YCAT;
    __device__ __forceinline__ void operator()(const pg::f32x4 (&acc)[2][2][4][2], const pg::Unit& u, int wr, int wc, int fr, int fq) const {
        const int row0 = u.pm * 256 + wr * 64 + fr, col0 = u.pn * 128 + wc * 32 + 8 * fq;
        const __amdgpu_buffer_rsrc_t rs = __builtin_amdgcn_make_buffer_rsrc(YCAT, 0, R * 1536 * 2, 0x00020000);
#pragma unroll
        for (int ai = 0; ai < 2; ++ai)
#pragma unroll
            for (int m = 0; m < 4; ++m) {
                pg::f32x4 v0, v1;
#pragma unroll
                for (int e = 0; e < 4; ++e) { v0[e] = acc[ai][0][m][0][e] * sigmoidf_(acc[ai][1][m][0][e]); v1[e] = acc[ai][0][m][1][e] * sigmoidf_(acc[ai][1][m][1][e]); }
                st16_wt(rs, (unsigned)(((row0 + ai * 128 + m * 16) * 1536 + 512 + col0) * 2), pack8(v0, v1));
            }
    }
};
struct MergeEpi {
    static constexpr bool MID = true;
    const bf16_t* Z; bf16_t* MERGED;
    __device__ __forceinline__ void mid(pg::f32x4 (&acc)[2][2][4][2], const pg::Unit& u, int t, int wr, int wc, int fr, int fq) const {
        const int nb = (t >> 3) - 1;
        int zz = 0; asm volatile("" : "+v"(zz));
        const int row0 = u.pm * 256 + wr * 64 + fr + zz, col0 = u.pn * 256 + wc * 32 + 8 * fq;
#pragma unroll
        for (int ai = 0; ai < 2; ++ai)
#pragma unroll
            for (int mp = 0; mp < 2; ++mp) {
                pg::u32x4 ra[2][2], rb[2][2];
#pragma unroll
                for (int mi = 0; mi < 2; ++mi)
#pragma unroll
                    for (int bj = 0; bj < 2; ++bj) {
                        const bf16_t* gp = Z + (size_t)(row0 + ai * 128 + (mp * 2 + mi) * 16) * 3072 + nb * 1024 + col0 + bj * 128;
                        ra[mi][bj] = *(const pg::u32x4*)gp; rb[mi][bj] = *(const pg::u32x4*)(gp + 1024);
                    }
#pragma unroll
                for (int mi = 0; mi < 2; ++mi)
#pragma unroll
                    for (int bj = 0; bj < 2; ++bj) {
                        const int m = mp * 2 + mi;
                        float ga[8], gb[8]; unpack8(ra[mi][bj], ga); unpack8(rb[mi][bj], gb);
#pragma unroll
                        for (int e = 0; e < 4; ++e) { acc[ai][bj][m][0][e] *= ga[e] * __builtin_amdgcn_rcpf(gb[e]); acc[ai][bj][m][1][e] *= ga[4 + e] * __builtin_amdgcn_rcpf(gb[4 + e]); }
                    }
                asm volatile("" ::: "memory");
            }
    }
    __device__ __forceinline__ void operator()(const pg::f32x4 (&acc)[2][2][4][2], const pg::Unit& u, int wr, int wc, int fr, int fq) const {
        const int row0 = u.pm * 256 + wr * 64 + fr, col0 = u.pn * 256 + wc * 32 + 8 * fq;
        const __amdgpu_buffer_rsrc_t rs = __builtin_amdgcn_make_buffer_rsrc(MERGED, 0, R * 1024 * 2, 0x00020000);
#pragma unroll
        for (int ai = 0; ai < 2; ++ai)
#pragma unroll
            for (int mp = 0; mp < 2; ++mp) {
                pg::u32x4 rg[2][2];
#pragma unroll
                for (int mi = 0; mi < 2; ++mi)
#pragma unroll
                    for (int bj = 0; bj < 2; ++bj) rg[mi][bj] = *(const pg::u32x4*)(Z + (size_t)(row0 + ai * 128 + (mp * 2 + mi) * 16) * 3072 + 2 * 1024 + col0 + bj * 128);
#pragma unroll
                for (int mi = 0; mi < 2; ++mi)
#pragma unroll
                    for (int bj = 0; bj < 2; ++bj) {
                        const int m = mp * 2 + mi;
                        float g[8]; unpack8(rg[mi][bj], g);
                        pg::f32x4 v0 = acc[ai][bj][m][0], v1 = acc[ai][bj][m][1];
#pragma unroll
                        for (int e = 0; e < 4; ++e) { v0[e] *= g[e]; v1[e] *= g[4 + e]; }
                        st16_wt(rs, (unsigned)(((row0 + ai * 128 + m * 16) * 1024 + col0 + bj * 128) * 2), pack8(v0, v1));
                    }
                asm volatile("" ::: "memory");
            }
    }
};
struct OutprojEpi {
    static constexpr bool MID = false;
    float* X; float* XC; const float* MODL;
    __device__ __forceinline__ void operator()(const pg::f32x4 (&acc)[2][2][4][2], const pg::Unit& u, int wr, int wc, int fr, int fq) const {
        const int row0 = u.pm * 256 + wr * 64 + fr, col0 = u.pn * 256 + wc * 32 + 8 * fq;
#pragma unroll
        for (int ai = 0; ai < 2; ++ai)
#pragma unroll
            for (int m = 0; m < 4; ++m) {
                const int row = row0 + ai * 128 + m * 16;
                float* dst = row < RL ? X + (size_t)row * D : XC + (size_t)(row - RL) * D;
                const float* gate = MODL + (size_t)(row < RL ? row / L : 4) * 6144 + 2048;
#pragma unroll
                for (int bj = 0; bj < 2; ++bj)
#pragma unroll
                    for (int n = 0; n < 2; ++n) {
                        const int col = col0 + bj * 128 + 4 * n;
                        pg::f32x4 v = *(pg::f32x4*)(dst + col); const pg::f32x4 gg = *(const pg::f32x4*)(gate + col);
                        v += gg * acc[ai][bj][m][n];
                        *(pg::f32x4*)(dst + col) = v;
                    }
            }
    }
};
struct GmoSched {
    const char *Gp, *GLUT, *YC, *BRT, *MG, *OUTT; unsigned* cnt; int G, c, nM, rev;
    __device__ __forceinline__ bool next(int i, pg::Unit& u) const {
        const int nU = nM * 4; int Lx, st;
        if (rev == 2) {
            const int lo = 240 + ((c - 240) & 3) + 8 * ((c - 240) >> 2);
            if (i == 0) { st = 0; Lx = c; }
            else if (i == 1) { if (c >= 240) { st = 0; Lx = 256 + (c - 240); } else { st = 1; Lx = c; } }
            else if (i == 2) { if (c >= 240) { st = 1; Lx = lo; } else if (c < 16) { st = 1; Lx = 244 + (c & 3) + 8 * (c >> 2); } else { st = 2; Lx = c - 16; } }
            else if (i == 3) { if (c >= 240) { st = 2; Lx = lo; } else if (c >= 16 && c < 32) { st = 2; Lx = 244 + ((c - 16) & 3) + 8 * ((c - 16) >> 2); } else if (c >= 32 && c < 48) { st = 2; Lx = 224 + (c - 32); } else return false; }
            else return false;
        } else {
            Lx = i * G + ((rev && (i & 1)) ? G - 1 - c : c);
            st = Lx / nU; if (st > 2) return false;
            Lx -= st * nU;
        }
        const int nctx = (nM - 64) * 4;
        if (Lx < nctx) { u.pm = 64 + Lx % (nM - 64 > 0 ? nM - 64 : 1); u.pn = Lx / (nM - 64 > 0 ? nM - 64 : 1); }
        else { const int j = Lx - nctx, x = j & 7, s = j >> 3; u.pm = x * 8 + (s >> 2); u.pn = s & 3; }
        u.aux = st; u.swap = 0;
        if (st == 0) { u.a = Gp + (size_t)u.pm * 256 * 512 * 2; u.b = GLUT + (size_t)u.pn * 256 * 512 * 2; u.K = 512; u.ldb = 512; }
        else if (st == 1) { u.a = YC + (size_t)u.pm * 256 * 1536 * 2; u.b = BRT + (size_t)u.pn * 256 * 1536 * 2; u.K = 1536; u.ldb = 1536; }
        else { u.a = MG + (size_t)u.pm * 256 * 1024 * 2; u.b = OUTT + (size_t)u.pn * 256 * 1024 * 2; u.K = 1024; u.ldb = 1024; }
        return true;
    }
    __device__ __forceinline__ unsigned a_off(const pg::Unit& u, int h, int R_, int C) const { return (unsigned)(((h * 128 + R_) * u.K + C) * 2); }
    __device__ __forceinline__ bool defer(const pg::Unit& u) const { return u.aux != 0; }
    __device__ __forceinline__ bool try_ready(const pg::Unit& u) const {
        if ((unsigned)__builtin_amdgcn_readfirstlane((int)__hip_atomic_load(cnt + (u.aux - 1) * 128 + u.pm, __ATOMIC_RELAXED, __HIP_MEMORY_SCOPE_AGENT)) < 4u) return false;
        return true;
    }
    __device__ __forceinline__ void wait_ready(const pg::Unit& u, int tid) const {
        if (u.aux == 0) return;
        if (tid < 64) {
            unsigned sp = 0;
            while ((unsigned)__builtin_amdgcn_readfirstlane((int)__hip_atomic_load(cnt + (u.aux - 1) * 128 + u.pm, __ATOMIC_RELAXED, __HIP_MEMORY_SCOPE_AGENT)) < 4u) { __builtin_amdgcn_s_sleep(2); if (++sp > (1u << 22)) break; }
        }
        asm volatile("" ::: "memory"); __builtin_amdgcn_s_barrier(); asm volatile("" ::: "memory");
    }
    __device__ __forceinline__ void publish(const pg::Unit& u, int tid) const {
        if (u.aux == 2) return;
        asm volatile("s_waitcnt vmcnt(0)" ::: "memory");
        __builtin_amdgcn_s_barrier();
        if (tid == 0) (void)__hip_atomic_fetch_add(cnt + u.aux * 128 + u.pm, 1u, __ATOMIC_RELAXED, __HIP_MEMORY_SCOPE_AGENT);
    }
};
struct GmoEpi {
    static constexpr bool MID = true;
    GluEpi EG; MergeEpi EM; OutprojEpi EO;
    __device__ __forceinline__ bool has_mid(const pg::Unit& u) const { return u.aux == 1; }
    __device__ __forceinline__ void mid(pg::f32x4 (&acc)[2][2][4][2], const pg::Unit& u, int t, int wr, int wc, int fr, int fq) const { EM.mid(acc, u, t, wr, wc, fr, fq); }
    __device__ __forceinline__ void operator()(const pg::f32x4 (&acc)[2][2][4][2], const pg::Unit& u, int wr, int wc, int fr, int fq) const {
        if (u.aux == 0) EG(acc, u, wr, wc, fr, fq);
        else if (u.aux == 1) EM(acc, u, wr, wc, fr, fq);
        else EO(acc, u, wr, wc, fr, fq);
    }
};
__device__ __forceinline__ void phase_fin(const Ctx& c, int l) {
    ret_finalize(c, l);
}
__device__ __forceinline__ void phase_gmo(const Ctx& c, int l) {
    const int nM = (l == 0) ? 68 : 64;
    GmoSched S{(const char*)cG(c), (const char*)cGLUT(c), (const char*)cYCAT(c), (const char*)cBRT(c), (const char*)cMERGED(c), (const char*)cOUTT(c),
               (unsigned*)(c.ws + OFF_CTL) + 12288 + l * 256, c.nblk, c.bid, nM, l == 0 ? (c.nblk == 256 ? 2 : 1) : 0};
    GmoEpi E{GluEpi{cYCAT(c)}, MergeEpi{cZGATE(c), cMERGED(c)}, OutprojEpi{c.X, cXC(c), cMOD(c) + (size_t)l * 5 * 6144}};
    const bool split = (l == 1 && c.nblk == 256);
    if (split && (c.bid & 7) < 4) { phase_convert(c, l, true, c.bid, c.nblk); __syncthreads(); }
    pg::gemm_phase_var((PG_LAS unsigned char*)c.smem, S, E, opq(c.tid));
    if (split) { if ((c.bid & 7) >= 4) phase_convert(c, l, true, c.bid, c.nblk); return; }
    if (l == 0 && c.nblk == 256) { if (c.bid >= 48 && c.bid < 240) phase_convert(c, l, true, c.bid - 48, 192); }
    else phase_convert(c, l, true);
}

__device__ __forceinline__ void moe_prefix(const Ctx& c, int l, int* sh) {
    __syncthreads();
    if (c.tid == 0) {
        int tp = 0;
        for (int e = 0; e < 32; ++e) { const int n = cCNT(c)[(l * 32 + e) * 64]; sh[e] = n; sh[32 + e] = tp; tp += (n + 255) >> 8; }
        sh[64] = tp;
    }
    __syncthreads();
}
struct MoeUpEpi {
    static constexpr bool MID = false;
    bf16_t* HID;
    __device__ __forceinline__ void operator()(const pg::f32x4 (&acc)[2][2][4][2], const pg::Unit& u, int wr, int wc, int fr, int fq) const {
        const int row0 = u.pm * 256 + wr * 64 + fr, col0 = u.pn * 128 + wc * 32 + 8 * fq;
        const __amdgpu_buffer_rsrc_t rs = __builtin_amdgcn_make_buffer_rsrc(HID, 0, 42752 * 512 * 2, 0x00020000);
#pragma unroll
        for (int ai = 0; ai < 2; ++ai)
#pragma unroll
            for (int m = 0; m < 4; ++m) {
                pg::f32x4 v0, v1;
#pragma unroll
                for (int e = 0; e < 4; ++e) { v0[e] = siluf_(acc[ai][0][m][0][e]) * acc[ai][1][m][0][e]; v1[e] = siluf_(acc[ai][0][m][1][e]) * acc[ai][1][m][1][e]; }
                st16_wt(rs, (unsigned)(((row0 + ai * 128 + m * 16) * 512 + col0) * 2), pack8(v0, v1));
            }
    }
};
struct MoeDnEpi {
    static constexpr bool MID = false;
    bf16_t* YBUF;
    __device__ __forceinline__ void operator()(const pg::f32x4 (&acc)[2][2][4][2], const pg::Unit& u, int wr, int wc, int fr, int fq) const {
        const int row0 = u.pm * 256 + wr * 64 + fr, col0 = u.pn * 256 + wc * 32 + 8 * fq;
#pragma unroll
        for (int ai = 0; ai < 2; ++ai)
#pragma unroll
            for (int m = 0; m < 4; ++m)
#pragma unroll
                for (int bj = 0; bj < 2; ++bj)
                    *(pg::u32x4*)(YBUF + (size_t)(row0 + ai * 128 + m * 16) * 1024 + col0 + bj * 128) = pack8(acc[ai][bj][m][0], acc[ai][bj][m][1]);
    }
};
struct MoeSched {
    const char* H; const char* UPT; const char* HID; const char* DNT; const int* SLOTTOK; const int* sh; unsigned* rdy; int G, c;
    __device__ __forceinline__ bool next(int i, pg::Unit& u) const {
        const int NU = sh[64] * 4; int Lx = i * G + c;
        const int ty = Lx >= NU ? 1 : 0; if (ty) Lx -= NU;
        if (Lx >= NU) return false;
        const int mtg = Lx >> 2; int e = 0;
#pragma unroll 1
        while (e < 31 && sh[32 + e + 1] <= mtg) ++e;
        u.pm = mtg; u.pn = Lx & 3; u.swap = ty;
        if (ty == 0) { u.aux = e | ((mtg - sh[32 + e]) << 8); u.a = H; u.b = UPT + ((size_t)e * 1024 + u.pn * 256) * 1024 * 2; u.K = 1024; u.ldb = 1024; }
        else { u.aux = e; u.a = HID + (size_t)mtg * 256 * 512 * 2; u.b = DNT + ((size_t)e * 1024 + u.pn * 256) * 512 * 2; u.K = 512; u.ldb = 512; }
        return true;
    }
    __device__ __forceinline__ unsigned a_off(const pg::Unit& u, int h, int R_, int C) const {
        if (u.swap) return (unsigned)(((h * 128 + R_) * 512 + C) * 2);
        const int e = u.aux & 255, pos = (u.aux >> 8) * 256 + h * 128 + R_;
        const int tok = pos < sh[e] ? (SLOTTOK[(size_t)e * SLOTCAP + pos] >> 1) : 0;
        return (unsigned)((tok * D + C) * 2);
    }
    __device__ __forceinline__ bool defer(const pg::Unit& u) const { return u.swap != 0; }
    __device__ __forceinline__ bool try_ready(const pg::Unit& u) const {
        if ((unsigned)__builtin_amdgcn_readfirstlane((int)__hip_atomic_load(rdy + u.pm, __ATOMIC_RELAXED, __HIP_MEMORY_SCOPE_AGENT)) < 4u) return false;
        return true;
    }
    __device__ __forceinline__ void wait_ready(const pg::Unit& u, int tid) const {
        if (!u.swap) return;
        if (tid < 64) {
            unsigned sp = 0;
            while ((unsigned)__builtin_amdgcn_readfirstlane((int)__hip_atomic_load(rdy + u.pm, __ATOMIC_RELAXED, __HIP_MEMORY_SCOPE_AGENT)) < 4u) { __builtin_amdgcn_s_sleep(2); if (++sp > (1u << 22)) break; }
        }
        asm volatile("" ::: "memory"); __builtin_amdgcn_s_barrier(); asm volatile("" ::: "memory");
    }
    __device__ __forceinline__ void publish(const pg::Unit& u, int tid) const {
        if (u.swap) return;
        asm volatile("s_waitcnt vmcnt(0)" ::: "memory");
        __builtin_amdgcn_s_barrier();
        if (tid == 0) (void)__hip_atomic_fetch_add(rdy + u.pm, 1u, __ATOMIC_RELAXED, __HIP_MEMORY_SCOPE_AGENT);
    }
};
struct MoeEpi {
    static constexpr bool MID = false;
    MoeUpEpi EU; MoeDnEpi ED;
    __device__ __forceinline__ void operator()(const pg::f32x4 (&acc)[2][2][4][2], const pg::Unit& u, int wr, int wc, int fr, int fq) const {
        if (u.swap) ED(acc, u, wr, wc, fr, fq); else EU(acc, u, wr, wc, fr, fq);
    }
};
__device__ __forceinline__ void phase_moe(const Ctx& c, int l) {
    int* sh = (int*)((unsigned char*)c.smem + LDS_SH);
    moe_prefix(c, l, sh);
    MoeSched S{(const char*)cH(c), (const char*)cUPT(c), (const char*)cHID(c), (const char*)cDNT(c), cSLOTTOK(c), sh, (unsigned*)(c.ws + OFF_CTL) + 13312 + l * 256, c.nblk, c.bid};
    MoeEpi E{MoeUpEpi{cHID(c)}, MoeDnEpi{cYBUF(c)}};
    pg::gemm_phase_var((PG_LAS unsigned char*)c.smem, S, E, opq(c.tid));
}
__device__ __forceinline__ void moe_prefix(const Ctx& c, int l, int* sh);
__device__ __forceinline__ void phase_combine(const Ctx& c, int l, const bool last) {
    int* sh = (int*)((unsigned char*)c.smem + LDS_SH);
    moe_prefix(c, l, sh);
    if (!last) phase_convert(c, l + 1, false);
    const int nrows = (l == 0) ? R : RL;
    const int gw = c.bid * 8 + c.wave, nw = c.nblk * 8;
    for (int r = gw; r < nrows; r += nw) {
        const int e0 = cROUTE_E(c)[r * 2], e1 = cROUTE_E(c)[r * 2 + 1];
        const float w0 = cROUTE_W(c)[r * 2], w1 = cROUTE_W(c)[r * 2 + 1];
        const bf16_t* y0p = cYBUF(c) + (size_t)(sh[32 + e0] * 256 + cSLOTPOS(c)[r * 2]) * 1024;
        const bf16_t* y1p = cYBUF(c) + (size_t)(sh[32 + e1] * 256 + cSLOTPOS(c)[r * 2 + 1]) * 1024;
        float* xr = r < RL ? c.X + (size_t)r * D : cXC(c) + (size_t)(r - RL) * D;
        const float* gg = cMOD(c) + (size_t)(l * 5 + (r < RL ? r / L : 4)) * 6144 + 5120;
        float y[16];
#pragma unroll
        for (int j = 0; j < 4; ++j) {
            const int d = (j * 64 + c.lane) * 4;
            const float4 xv = *(const float4*)(xr + d), g4 = *(const float4*)(gg + d);
            const uint2 a = *(const uint2*)(y0p + d), b = *(const uint2*)(y1p + d);
            y[j * 4 + 0] = xv.x + g4.x * (w0 * __uint_as_float(a.x << 16) + w1 * __uint_as_float(b.x << 16));
            y[j * 4 + 1] = xv.y + g4.y * (w0 * __uint_as_float(a.x & 0xffff0000u) + w1 * __uint_as_float(b.x & 0xffff0000u));
            y[j * 4 + 2] = xv.z + g4.z * (w0 * __uint_as_float(a.y << 16) + w1 * __uint_as_float(b.y << 16));
            y[j * 4 + 3] = xv.w + g4.w * (w0 * __uint_as_float(a.y & 0xffff0000u) + w1 * __uint_as_float(b.y & 0xffff0000u));
        }
        if (!last) {
#pragma unroll
            for (int j = 0; j < 4; ++j) *(float4*)(xr + (j * 64 + c.lane) * 4) = make_float4(y[j * 4], y[j * 4 + 1], y[j * 4 + 2], y[j * 4 + 3]);
            norm_apply(c, l + 1, r, 0, y);
#pragma unroll
            for (int j = 0; j < 4; ++j) store_bf4(cH(c) + (size_t)r * D + (j * 64 + c.lane) * 4, y[j * 4], y[j * 4 + 1], y[j * 4 + 2], y[j * 4 + 3]);
        } else {
            float ss = 0.f;
#pragma unroll
            for (int i = 0; i < 16; ++i) ss += y[i] * y[i];
            ss = wave_sum(ss, c.lane);
            float rinv = rsqrtf(ss * (1.0f / 1024.0f) + 1e-6f);
#pragma unroll
            for (int j = 0; j < 4; ++j) {
                const float4 fg = *(const float4*)(c.p->in[I_FNG] + (j * 64 + c.lane) * 4);
                *(float4*)(xr + (j * 64 + c.lane) * 4) = make_float4(y[j * 4] * rinv * fg.x, y[j * 4 + 1] * rinv * fg.y, y[j * 4 + 2] * rinv * fg.z, y[j * 4 + 3] * rinv * fg.w);
            }
        }
    }
}

#define XB_TMO      128
#define XB_XCNT(j)  (256  + 64 * (j))
#define XB_XSUB(j)  (1280 + 64 * (j))
#define XB_XGEN(j)  (2304 + 64 * (j))
#define XB_TOP      3328
#define XB_TOPGEN   3392
#define XCD_BAR_WORDS 3456
#define XB_SPIN_CAP (1u << 18)
#define LAS __attribute__((address_space(3)))
__device__ __forceinline__ unsigned xb_ld(unsigned* p)              { return __hip_atomic_load(p, __ATOMIC_RELAXED, __HIP_MEMORY_SCOPE_AGENT); }
__device__ __forceinline__ unsigned xb_add(unsigned* p, unsigned v) { return __hip_atomic_fetch_add(p, v, __ATOMIC_RELAXED, __HIP_MEMORY_SCOPE_AGENT); }
__device__ __forceinline__ unsigned xb_xcc_id() { return (unsigned)__builtin_amdgcn_s_getreg((3 << 11) | 20) & 0xFu; }
#define XB_SPIN(cond, bar) do { unsigned _sp = 0; while (cond) { __builtin_amdgcn_s_sleep(1); \
    if ((++_sp & 255u) == 0u) { if (xb_ld(&(bar)[XB_TMO])) break; if (_sp > XB_SPIN_CAP) { atomicAdd(&(bar)[XB_TMO], 1u); break; } } } } while (0)
struct XcdBarrier { unsigned* bar; unsigned x; volatile LAS unsigned* st; };
__device__ __forceinline__ XcdBarrier xcd_barrier_post(unsigned* bar, volatile LAS unsigned* st, const bool t0) {
    XcdBarrier b; b.bar = bar; b.x = xb_xcc_id(); b.st = st;
    if (t0) (void)xb_add(&bar[XB_XCNT(b.x)], 1u);
    return b;
}
__device__ __forceinline__ void xcd_barrier_complete(unsigned* bar, unsigned x, unsigned& nloc, unsigned& nx) {
    const unsigned G = gridDim.x * gridDim.y * gridDim.z;
    unsigned sum, cnt, mine, sp = 0u;
    for (;;) {
        sum = 0u; cnt = 0u; mine = 0u;
#pragma unroll
        for (unsigned j = 0; j < 16; ++j) { const unsigned c = xb_ld(&bar[XB_XCNT(j)]); sum += c; cnt += (c > 0u) ? 1u : 0u; mine = (j == x) ? c : mine; }
        if (sum == G) break;
        __builtin_amdgcn_s_sleep(1);
        if ((++sp & 255u) == 0u) { if (xb_ld(&bar[XB_TMO])) break; if (sp > XB_SPIN_CAP) { atomicAdd(&bar[XB_TMO], 1u); break; } }
    }
    nloc = mine > 0u ? mine : 1u; nx = cnt > 0u ? cnt : 1u;
}
__device__ __forceinline__ void xcd_barrier(const XcdBarrier& b, const bool t0) {
    asm volatile("s_waitcnt vmcnt(0)" ::: "memory");
    __syncthreads();
    if (t0) {
        unsigned* bar = b.bar;
        __builtin_amdgcn_s_waitcnt(0);
        unsigned nloc = b.st[0], nx = b.st[1];
        if (nloc == 0u) { xcd_barrier_complete(bar, b.x, nloc, nx); b.st[0] = nloc; b.st[1] = nx; }
        const unsigned old = xb_add(&bar[XB_XSUB(b.x)], 1u);
        const unsigned gen = old / nloc;
        if (old + 1u == (gen + 1u) * nloc) {
            __builtin_amdgcn_fence(__ATOMIC_RELEASE, "agent");
            asm volatile("s_waitcnt vmcnt(0)" ::: "memory");
            asm volatile("buffer_inv sc1" ::: "memory");
            const unsigned og = xb_add(&bar[XB_TOP], 1u);
            const unsigned tg = og / nx;
            if (og + 1u == (tg + 1u) * nx) {
#pragma unroll
                for (unsigned j = 0; j < 16; ++j) xb_add(&bar[XB_XGEN(j)], 1u);
            } else XB_SPIN(xb_ld(&bar[XB_XGEN(b.x)]) == gen, bar);
            asm volatile("s_waitcnt vmcnt(0)" ::: "memory");
        } else {
            asm volatile("buffer_inv sc1" ::: "memory");
            XB_SPIN(xb_ld(&bar[XB_XGEN(b.x)]) == gen, bar);
            asm volatile("s_waitcnt vmcnt(0)" ::: "memory");
        }
    }
    __syncthreads();
}

__global__ void __launch_bounds__(NT) mega(Params p) {
    extern __shared__ __attribute__((aligned(16))) unsigned char lds_raw[];
    Ctx c;
    cg::grid_group grid = cg::this_grid();
    volatile LAS unsigned* xst = (volatile LAS unsigned*)((LAS unsigned char*)lds_raw + (LDS_BYTES - 16));
    const int wave_s = __builtin_amdgcn_readfirstlane((int)threadIdx.x >> 6);
#define LANEID() ([&]() { int z_ = 0; asm volatile("" : "+s"(z_)); return (int)__builtin_amdgcn_mbcnt_hi(~0u, __builtin_amdgcn_mbcnt_lo(~0u, (unsigned)z_)); }())
#define T0 (wave_s == 0 && LANEID() == 0)
    if (wave_s == 0 && LANEID() < 4) xst[LANEID()] = 0u;
    __syncthreads();
    const XcdBarrier xbar = xcd_barrier_post((unsigned*)(p.ws + OFF_CTL) + 8192, xst, T0);
#define OPAQUE() do { int zo = 0; asm volatile("" : "+s"(zo)); int zv = 0; asm volatile("" : "+v"(zv)); \
        c.p = (KParams)((const __attribute__((address_space(4))) unsigned char*)__builtin_amdgcn_kernarg_segment_ptr() + zo); \
        c.ws = p.ws + zo; c.X = p.out + zo; c.smem = (float*)(lds_raw + zo); \
        c.tid = wave_s * 64 + LANEID() + zv; c.lane = c.tid & 63; c.wave = __builtin_amdgcn_readfirstlane(c.tid >> 6); c.bid = (int)blockIdx.x + zo; c.nblk = (int)gridDim.x + zo; } while (0)
#define PH(k, call) { OPAQUE(); call; if ((k) + 1 < NPHASE) { if ((k) == 0) grid.sync(); else xcd_barrier(xbar, T0); } }
    PH(0, phase_init(c))
    PH(1, phase_norm1(c, 0))
#define LAYER(l, b) \
    PH(b + 0, phase_inproj(c, l)) PH(b + 1, phase_mixA(c, l)) PH(b + 2, phase_mixB(c, l)) PH(b + 3, phase_mixC(c, l)) PH(b + 4, phase_gmo(c, l)) \
    PH(b + 5, phase_norm2_route(c, l)) PH(b + 6, phase_moe(c, l))
    LAYER(0, 2)
    PH(9, phase_combine(c, 0, false))
    LAYER(1, 10)
    PH(17, phase_combine(c, 1, true))
}

extern "C" void kernel_launch(void* const* d_in, const int* in_sizes, int n_in, void* d_out, int out_size, void* d_ws, size_t ws_size, hipStream_t stream) {
    static int grid = 0;
    if (grid == 0) {
        if (n_in != N_IN || out_size != RL * D || ws_size < WS_NEED) { fprintf(stderr, "kernel_launch: unexpected shapes n_in %d out %d ws %zu\n", n_in, out_size, ws_size); grid = -1; return; }
        int dev = 0, cus = 0, per_cu = 0;
        hipGetDevice(&dev); hipDeviceGetAttribute(&cus, hipDeviceAttributeMultiprocessorCount, dev);
        hipFuncSetAttribute((const void*)mega, hipFuncAttributeMaxDynamicSharedMemorySize, LDS_BYTES);
        hipOccupancyMaxActiveBlocksPerMultiprocessor(&per_cu, (const void*)mega, NT, LDS_BYTES);
        if (per_cu < 1) { fprintf(stderr, "kernel_launch: occupancy query says %d\n", per_cu); grid = -1; return; }
        grid = cus;
    }
    if (grid < 0) return;
    if (hipMemsetAsync((unsigned char*)d_ws + OFF_CTL, 0, 65536, stream) != hipSuccess) { fprintf(stderr, "kernel_launch: memset failed\n"); return; }
    Params p{};
    for (int i = 0; i < N_IN; ++i) p.in[i] = (const float*)d_in[i];
    p.out = (float*)d_out; p.ws = (unsigned char*)d_ws;
    void* args[] = {&p};
    hipError_t e = hipLaunchCooperativeKernel((const void*)mega, dim3(grid), dim3(NT), args, LDS_BYTES, stream);
    if (e != hipSuccess) fprintf(stderr, "cooperative launch failed: %s\n", hipGetErrorString(e));
}
```
